# Optimizing an MI355X kernel written in HIP

```python
import math
import jax, jax.numpy as jnp
from jax import lax
import numpy as np

D_MODEL = 1024
BATCH = 8
SEQ = 4096
DEPTH = 2

N_MIXERS = 2
HEAD_DIM_A = 64
DIL_GROUPS = ((128, 1), (512, 4), (2048, 16))
HEADS_PER_GROUP_A = 6
N_HEADS_A = HEADS_PER_GROUP_A * len(DIL_GROUPS)
WIDTH_A = N_HEADS_A * HEAD_DIM_A
N_BUCKETS = 32
T5_MAX_DISTANCE = 1024
N_HEADS_B = 16
QK_NOPE_DIM = 64
QK_ROPE_DIM = 32
V_HEAD_DIM = 64
Q_LORA_RANK = 256
KV_LORA_RANK = 128
WIDTH_B = N_HEADS_B * V_HEAD_DIM
IN_B = Q_LORA_RANK + KV_LORA_RANK + QK_ROPE_DIM + WIDTH_B
ROPE_THETA = 10000.0
Q_BLOCK = 128
DEPTH_A = (DEPTH + N_MIXERS - 1) // N_MIXERS
DEPTH_B = DEPTH // N_MIXERS
DEEPNORM_ALPHA = (2.0 * DEPTH) ** 0.25
DEEPNORM_BETA = (8.0 * DEPTH) ** -0.25
LN_EPS = 1e-5
RMS_EPS = 1e-6
NEG_INF = -1e30

kernel_name = "hybrid_dilated_mla_encoder"


def layernorm(x, g, b):
    xf = x.astype(jnp.float32)
    mu = xf.mean(-1, keepdims=True)
    var = jnp.square(xf - mu).mean(-1, keepdims=True)
    return ((xf - mu) * lax.rsqrt(var + LN_EPS) * g.astype(jnp.float32) + b.astype(jnp.float32)).astype(x.dtype)


def rmsnorm(x, g):
    xf = x.astype(jnp.float32)
    return (xf * lax.rsqrt(jnp.square(xf).mean(-1, keepdims=True) + RMS_EPS) * g.astype(jnp.float32)).astype(x.dtype)


def t5_bucket(rel):
    half = N_BUCKETS // 2
    max_exact = half // 2
    base = jnp.where(rel > 0, half, 0)
    n = jnp.abs(rel)
    nf = jnp.maximum(n, 1).astype(jnp.float32)
    large = max_exact + (jnp.log(nf / max_exact) / math.log(T5_MAX_DISTANCE / max_exact)
                         * (half - max_exact)).astype(jnp.int32)
    large = jnp.minimum(large, half - 1)
    return base + jnp.where(n < max_exact, n, large)


def dilated_window_attention(q, k, v, bias_table, window, dil):
    B, S, H, Dh = q.shape
    R = window // (2 * dil)
    L = S // dil
    nb = -(-L // R)
    Lp = nb * R

    def to_sub(t):
        return t.reshape(B, L, dil, H, Dh).transpose(0, 2, 3, 1, 4)

    qs = jnp.pad(to_sub(q), ((0, 0), (0, 0), (0, 0), (0, Lp - L), (0, 0))).reshape(B, dil, H, nb, R, Dh)

    def key_blocks(t):
        tp = jnp.pad(to_sub(t), ((0, 0), (0, 0), (0, 0), (R, Lp - L + R), (0, 0))).reshape(B, dil, H, nb + 2, R, Dh)
        return jnp.concatenate([tp[:, :, :, :-2], tp[:, :, :, 1:-1], tp[:, :, :, 2:]], axis=4)

    kb = key_blocks(k)
    vb = key_blocks(v)
    a = jnp.arange(R)[:, None]
    bk = jnp.arange(3 * R)[None, :]
    off = bk - R - a
    kpos = jnp.arange(nb)[:, None, None] * R + bk[None] - R
    valid = (jnp.abs(off) <= R)[None] & (kpos >= 0) & (kpos < L)
    bias = bias_table[t5_bucket(off * dil)].transpose(2, 0, 1).astype(jnp.float32)

    s = jnp.einsum('bdhnqe,bdhnke->bdhnqk', qs, kb).astype(jnp.float32) * (Dh ** -0.5) + bias[:, None]
    s = jnp.where(valid, s, NEG_INF)
    m = s.max(-1, keepdims=True)
    p = jnp.exp(s - m)
    denom = p.sum(-1, keepdims=True)
    o = jnp.einsum('bdhnqk,bdhnke->bdhnqe', p, vb.astype(jnp.float32)) / denom
    lse = (m + jnp.log(denom))[..., 0]

    def from_sub(t):
        t = t.reshape(B, dil, H, Lp, *t.shape[5:])[:, :, :, :L]
        t = jnp.moveaxis(t, 3, 1)
        return t.reshape(B, S, H, *t.shape[4:])

    return from_sub(o).astype(q.dtype), from_sub(lse)


def mixer_dilated(u, w_in, w_out, rel_bias):
    B, S, _ = u.shape
    q, k, v, gate = jnp.split(u @ w_in, 4, axis=-1)
    q = q.reshape(B, S, N_HEADS_A, HEAD_DIM_A)
    k = k.reshape(B, S, N_HEADS_A, HEAD_DIM_A)
    v = v.reshape(B, S, N_HEADS_A, HEAD_DIM_A)
    outs, lses = [], []
    for g, (window, dil) in enumerate(DIL_GROUPS):
        hs = slice(g * HEADS_PER_GROUP_A, (g + 1) * HEADS_PER_GROUP_A)
        o, l = dilated_window_attention(q[:, :, hs], k[:, :, hs], v[:, :, hs], rel_bias[:, hs], window, dil)
        outs.append(o)
        lses.append(l)
    wts = jax.nn.softmax(jnp.stack(lses, axis=0), axis=0).astype(u.dtype)
    o = jnp.concatenate([outs[g] * wts[g][..., None] for g in range(len(DIL_GROUPS))], axis=2)
    y = o.reshape(B, S, WIDTH_A) * jax.nn.silu(gate)
    return y @ w_out


def rope(x, cos, sin):
    half = x.shape[-1] // 2
    x1, x2 = x[..., :half], x[..., half:]
    return jnp.concatenate([x1 * cos - x2 * sin, x2 * cos + x1 * sin], axis=-1)


def mixer_mla(u, w_in, q_norm, w_uq, kv_norm, w_ukv, w_out):
    B, S, _ = u.shape
    cq, ckv, k_rope, gate = jnp.split(
        u @ w_in, [Q_LORA_RANK, Q_LORA_RANK + KV_LORA_RANK, Q_LORA_RANK + KV_LORA_RANK + QK_ROPE_DIM], axis=-1)
    q = (rmsnorm(cq, q_norm) @ w_uq).reshape(B, S, N_HEADS_B, QK_NOPE_DIM + QK_ROPE_DIM)
    q_nope, q_rope = q[..., :QK_NOPE_DIM], q[..., QK_NOPE_DIM:]
    kv = (rmsnorm(ckv, kv_norm) @ w_ukv).reshape(B, S, N_HEADS_B, QK_NOPE_DIM + V_HEAD_DIM)
    k_nope, v = kv[..., :QK_NOPE_DIM], kv[..., QK_NOPE_DIM:]

    pos = jnp.arange(S, dtype=jnp.float32)
    inv_freq = ROPE_THETA ** (-jnp.arange(0, QK_ROPE_DIM, 2, dtype=jnp.float32) / QK_ROPE_DIM)
    ang = pos[:, None] * inv_freq[None, :]
    cos, sin = jnp.cos(ang).astype(u.dtype), jnp.sin(ang).astype(u.dtype)
    q_rope = rope(q_rope, cos[:, None], sin[:, None])
    k_rope = rope(k_rope, cos, sin)

    scale = (QK_NOPE_DIM + QK_ROPE_DIM) ** -0.5
    nq = S // Q_BLOCK
    qn_b = q_nope.reshape(B, nq, Q_BLOCK, N_HEADS_B, QK_NOPE_DIM).transpose(1, 0, 2, 3, 4)
    qr_b = q_rope.reshape(B, nq, Q_BLOCK, N_HEADS_B, QK_ROPE_DIM).transpose(1, 0, 2, 3, 4)

    def block(args):
        qn, qr = args
        s = (jnp.einsum('bqhd,bkhd->bhqk', qn, k_nope)
             + jnp.einsum('bqhd,bkd->bhqk', qr, k_rope)).astype(jnp.float32) * scale
        p = jax.nn.softmax(s, axis=-1).astype(v.dtype)
        return jnp.einsum('bhqk,bkhd->bqhd', p, v)

    o = lax.map(block, (qn_b, qr_b))
    o = o.transpose(1, 0, 2, 3, 4).reshape(B, S, WIDTH_B)
    y = o * jax.nn.silu(gate)
    return y @ w_out


def setup_inputs(seed: int = 0) -> dict:
    key = jax.random.key(seed)
    ks = jax.random.split(key, 20)
    nrm = jax.random.normal
    D = D_MODEL
    x = nrm(ks[0], (BATCH, SEQ, D), jnp.float32)
    c = nrm(ks[1], (BATCH, D), jnp.float32)
    rel_bias = 0.2 * nrm(ks[2], (N_BUCKETS, N_HEADS_A), jnp.float32)
    ada_w = 0.5 * D ** -0.5 * nrm(ks[3], (DEPTH, D, 3 * D), jnp.float32)
    ada_b = 0.02 * nrm(ks[4], (DEPTH, 3 * D), jnp.float32)
    ln_g = 1.0 + 0.05 * nrm(ks[5], (DEPTH, D), jnp.float32)
    ln_b = 0.02 * nrm(ks[6], (DEPTH, D), jnp.float32)
    a_w_in = D ** -0.5 * nrm(ks[7], (DEPTH_A, D, 4 * WIDTH_A), jnp.float32)
    a_w_in = a_w_in.at[:, :, 2 * WIDTH_A:3 * WIDTH_A].multiply(DEEPNORM_BETA)
    a_w_out = DEEPNORM_BETA * WIDTH_A ** -0.5 * nrm(ks[8], (DEPTH_A, WIDTH_A, D), jnp.float32)
    b_w_in = D ** -0.5 * nrm(ks[9], (DEPTH_B, D, IN_B), jnp.float32)
    b_q_norm = 1.0 + 0.05 * nrm(ks[10], (DEPTH_B, Q_LORA_RANK), jnp.float32)
    b_w_uq = Q_LORA_RANK ** -0.5 * nrm(ks[11], (DEPTH_B, Q_LORA_RANK, N_HEADS_B * (QK_NOPE_DIM + QK_ROPE_DIM)), jnp.float32)
    b_kv_norm = 1.0 + 0.05 * nrm(ks[12], (DEPTH_B, KV_LORA_RANK), jnp.float32)
    b_w_ukv = KV_LORA_RANK ** -0.5 * nrm(ks[13], (DEPTH_B, KV_LORA_RANK, N_HEADS_B, QK_NOPE_DIM + V_HEAD_DIM), jnp.float32)
    b_w_ukv = b_w_ukv.at[..., QK_NOPE_DIM:].multiply(DEEPNORM_BETA).reshape(
        DEPTH_B, KV_LORA_RANK, N_HEADS_B * (QK_NOPE_DIM + V_HEAD_DIM))
    b_w_out = DEEPNORM_BETA * WIDTH_B ** -0.5 * nrm(ks[14], (DEPTH_B, WIDTH_B, D), jnp.float32)
    return {"x": x, "c": c, "rel_bias": rel_bias, "ada_w": ada_w, "ada_b": ada_b,
            "ln_g": ln_g, "ln_b": ln_b, "a_w_in": a_w_in, "a_w_out": a_w_out,
            "b_w_in": b_w_in, "b_q_norm": b_q_norm, "b_w_uq": b_w_uq, "b_kv_norm": b_kv_norm,
            "b_w_ukv": b_w_ukv, "b_w_out": b_w_out}


def reference(x, c, rel_bias, ada_w, ada_b, ln_g, ln_b, a_w_in, a_w_out,
              b_w_in, b_q_norm, b_w_uq, b_kv_norm, b_w_ukv, b_w_out):
    for i in range(DEPTH):
        mod = jax.nn.silu(c) @ ada_w[i] + ada_b[i]
        shift, scale, gate = jnp.split(mod[:, None, :], 3, axis=-1)
        u = x * (1 + scale) + shift
        j = i // N_MIXERS
        if i % N_MIXERS == 0:
            y = mixer_dilated(u, a_w_in[j], a_w_out[j], rel_bias)
        else:
            y = mixer_mla(u, b_w_in[j], b_q_norm[j], b_w_uq[j], b_kv_norm[j], b_w_ukv[j], b_w_out[j])
        x = layernorm(DEEPNORM_ALPHA * x + gate * y, ln_g[i], ln_b[i])
    return x
```

```cpp
#include <hip/hip_runtime.h>
#include <cstdio>
#include <cstdint>

#ifndef MK_PER_PHASE
#define MK_PER_PHASE 0
#endif
#ifndef SELFCHECK
#define SELFCHECK 0
#endif

#define GAS __attribute__((address_space(1)))
#define LAS __attribute__((address_space(3)))

namespace pg8 {
typedef unsigned short bf16_t;
typedef short bf16x8 __attribute__((ext_vector_type(8)));
typedef float f32x4 __attribute__((ext_vector_type(4)));
typedef unsigned u32x4 __attribute__((ext_vector_type(4)));
constexpr int BM = 256, BK = 64, HALF = 128, HTB = HALF * BK * 2, STAGE_BYTES = 8 * HTB, NXCD = 8, WGM = 8;

__host__ __device__ __forceinline__ int lds_byte(int r, int c) { const int st = (r >> 4) * 2 + (c >> 5), rr = r & 15, cc = c & 31, ob = rr * 64 + cc * 2; return st * 1024 + (ob ^ (((ob >> 9) & 1) << 5)); }
__host__ __device__ __forceinline__ void stage_rc(int b, int& R, int& C) { const int st = b / 1024, sb = b % 1024, swz = sb ^ (((sb >> 9) & 1) << 5); R = (st >> 1) * 16 + swz / 64; C = (st & 1) * 32 + (swz % 64) / 2; }
__host__ __device__ __forceinline__ int perm32(int rho) { const int n = rho >> 4, i = rho & 15; return 8 * (i >> 2) + 4 * n + (i & 3); }

struct Unit { int pm, pn; };
struct Gemm { const bf16_t* A; const bf16_t* Bt; int M, N, K, lda; };

struct StaticOrder {
    int nM, nN, nwg, G, c;
    __host__ __device__ void init(int M, int N, int G_, int c_) { nM = M / BM; nN = N / BM; nwg = nM * nN; G = G_; c = c_; }
    __host__ __device__ bool next(int i, Unit& u) const {
        const long L = (long)i * G + c; if (L >= nwg) return false;
        int wgid = (int)L; { const int q = nwg / NXCD, r = nwg % NXCD, xcd = wgid % NXCD, off = wgid / NXCD; wgid = (xcd < r ? xcd * (q + 1) : r * (q + 1) + (xcd - r) * q) + off; }
        const int nig = WGM * nN, gid = wgid / nig, fm = gid * WGM, gsz = (nM - fm) < WGM ? (nM - fm) : WGM;
        u.pm = fm + ((wgid % nig) % gsz); u.pn = (wgid % nig) / gsz; return true;
    }
};

__device__ __forceinline__ unsigned cvt_pk_bf16(float lo, float hi) { unsigned r; asm volatile("v_cvt_pk_bf16_f32 %0, %1, %2" : "=v"(r) : "v"(lo), "v"(hi)); return r; }

struct EpiBf16 {
    static constexpr bool PERM = true;
    bf16_t* O; int ldc;
    __device__ __forceinline__ void operator()(const f32x4 (&acc)[2][2][4][2], const Unit& u, int wr, int wc, int fr, int fq) const {
        const int row0 = u.pm * BM + wr * 64 + fr; const int col0 = u.pn * BM + wc * 32 + 8 * fq;
#pragma unroll
        for (int ai = 0; ai < 2; ++ai)
#pragma unroll
            for (int m = 0; m < 4; ++m) { bf16_t* rowp = O + (size_t)(row0 + ai * HALF + m * 16) * ldc + col0;
#pragma unroll
                for (int bj = 0; bj < 2; ++bj) { const f32x4 v0 = acc[ai][bj][m][0], v1 = acc[ai][bj][m][1];
                    u32x4 w; w.x = cvt_pk_bf16(v0[0], v0[1]); w.y = cvt_pk_bf16(v0[2], v0[3]); w.z = cvt_pk_bf16(v1[0], v1[1]); w.w = cvt_pk_bf16(v1[2], v1[3]);
                    *(u32x4*)(rowp + bj * HALF) = w; } }
    }
};

template <class Epi, class Sched, bool ALIGN_EPI = true>
__device__ __forceinline__ void gemm_phase(LAS unsigned char* lds, const Gemm g, const Sched& S, const Epi& E) {
    const int tid = threadIdx.x, wid = __builtin_amdgcn_readfirstlane(tid >> 6), lane = tid & 63, wr = wid >> 2, wc = wid & 3, fr = lane & 15, fq = lane >> 4;
    const int K = g.K, nt = K / BK;
    unsigned voffA[2], voffB[2];
#pragma unroll
    for (int i = 0; i < 2; ++i) { int R, C; stage_rc(tid * 16 + i * 8192, R, C); const int Rb = Epi::PERM ? ((R & ~31) + perm32(R & 31)) : R;
        voffA[i] = (unsigned)(R * g.lda + C) * 2u; voffB[i] = (unsigned)(Rb * K + C) * 2u; }
    const size_t kstep = (size_t)(BK * 2);
    const size_t hstepA = (size_t)HALF * g.lda * 2, hstepB = (size_t)HALF * K * 2;
    const size_t tstepA = 2 * hstepA, tstepB = 2 * hstepB;
    const unsigned ldsw = (unsigned)wid * 1024u;
    const int aoff = lds_byte(wr * 64 + fr, fq * 8), boff = lds_byte(wc * 32 + fr, fq * 8);
#define PG8_SA(b, h) (((b) * 2 + (h)) * HTB)
#define PG8_SB(b, h) ((4 + (b) * 2 + (h)) * HTB)
#define PG8_STAGE(bufoff, gbase, voff) do { _Pragma("unroll") for (int _i = 0; _i < 2; ++_i) \
        __builtin_amdgcn_global_load_lds((const unsigned*)((const char*)(gbase) + (voff)[_i]), (LAS unsigned*)(lds + (bufoff) + ldsw + _i * 8192), 16, 0, 0); } while (0)
#define PG8_LDA(dst, b, h) do { _Pragma("unroll") for (int m = 0; m < 4; ++m) _Pragma("unroll") for (int k = 0; k < 2; ++k) dst[m][k] = *(const LAS bf16x8*)(lds + PG8_SA(b, h) + aoff + m * 2048 + k * 1024); } while (0)
#define PG8_LDB(dst, b, h) do { _Pragma("unroll") for (int n = 0; n < 2; ++n) _Pragma("unroll") for (int k = 0; k < 2; ++k) dst[n][k] = *(const LAS bf16x8*)(lds + PG8_SB(b, h) + boff + n * 2048 + k * 1024); } while (0)
#define PG8_MMA(ai, bj, At, Bt) do { __builtin_amdgcn_s_setprio(1); _Pragma("unroll") for (int m = 0; m < 4; ++m) _Pragma("unroll") for (int n = 0; n < 2; ++n) _Pragma("unroll") for (int k = 0; k < 2; ++k) \
        acc[ai][bj][m][n] = __builtin_amdgcn_mfma_f32_16x16x32_bf16(Bt[n][k], At[m][k], acc[ai][bj][m][n], 0, 0, 0); __builtin_amdgcn_s_setprio(0); } while (0)
#define PG8_WAIT_V(n) asm volatile("s_waitcnt vmcnt(" #n ")" ::: "memory")
#define PG8_WAIT_L(n) asm volatile("s_waitcnt lgkmcnt(" #n ")" ::: "memory")
#define PG8_BAR __builtin_amdgcn_s_barrier()
#define PG8_SCHED __builtin_amdgcn_sched_barrier(0)
    Unit cur, nxt; int ui = 0;
    if (!S.next(0, cur)) return;
    f32x4 acc[2][2][4][2];
#pragma unroll
    for (int a = 0; a < 2; ++a)
#pragma unroll
        for (int b = 0; b < 2; ++b)
#pragma unroll
            for (int m = 0; m < 4; ++m)
#pragma unroll
                for (int n = 0; n < 2; ++n) acc[a][b][m][n] = (f32x4){0.f, 0.f, 0.f, 0.f};
    bf16x8 At[4][2], B0[2][2], B1[2][2];
    const char* cA = (const char*)g.A + (size_t)cur.pm * tstepA; const char* cB = (const char*)g.Bt + (size_t)cur.pn * tstepB;
    PG8_STAGE(PG8_SB(0, 0), cB, voffB); PG8_STAGE(PG8_SB(0, 1), cB + hstepB, voffB); PG8_STAGE(PG8_SA(0, 0), cA, voffA); PG8_STAGE(PG8_SA(0, 1), cA + hstepA, voffA);
    if (wr == 1) PG8_BAR;
    PG8_WAIT_V(2); PG8_BAR;
    PG8_STAGE(PG8_SB(1, 0), cB + kstep, voffB); PG8_STAGE(PG8_SA(1, 0), cA + kstep, voffA); PG8_STAGE(PG8_SB(1, 1), cB + hstepB + kstep, voffB);
    PG8_WAIT_V(6); PG8_BAR;
    for (;;) {
        const bool has_next = S.next(ui + 1, nxt);
        const char* nA = has_next ? (const char*)g.A + (size_t)nxt.pm * tstepA : cA; const char* nB = has_next ? (const char*)g.Bt + (size_t)nxt.pn * tstepB : cB;
        for (int t = 0; t < nt; t += 2) {
            const bool last = (t == nt - 2);
            const char* a1 = cA + (size_t)(t + 1) * kstep;
            const char* a2 = last ? nA : cA + (size_t)(t + 2) * kstep; const char* b2 = last ? nB : cB + (size_t)(t + 2) * kstep;
            const char* a3 = a2 + kstep; const char* b3 = b2 + kstep;
            PG8_LDB(B0, 0, 0); PG8_LDB(B1, 0, 1); PG8_SCHED; PG8_LDA(At, 0, 0); PG8_STAGE(PG8_SA(1, 1), a1 + hstepA, voffA);
            PG8_WAIT_V(8); PG8_WAIT_L(0); PG8_BAR; PG8_MMA(0, 0, At, B0); PG8_MMA(0, 1, At, B1); PG8_BAR; PG8_SCHED;
            PG8_LDA(At, 0, 1); PG8_STAGE(PG8_SB(0, 0), b2, voffB); PG8_STAGE(PG8_SB(0, 1), b2 + hstepB, voffB); PG8_STAGE(PG8_SA(0, 0), a2, voffA);
            PG8_WAIT_V(8); PG8_WAIT_L(0); PG8_BAR; PG8_MMA(1, 0, At, B0); PG8_MMA(1, 1, At, B1); PG8_BAR; PG8_SCHED;
            PG8_LDB(B0, 1, 0); PG8_LDB(B1, 1, 1); PG8_SCHED; PG8_LDA(At, 1, 0); PG8_STAGE(PG8_SA(0, 1), a2 + hstepA, voffA);
            PG8_WAIT_V(8); PG8_WAIT_L(0); PG8_BAR; PG8_MMA(0, 0, At, B0); PG8_MMA(0, 1, At, B1); PG8_BAR; PG8_SCHED;
            PG8_LDA(At, 1, 1); PG8_STAGE(PG8_SB(1, 0), b3, voffB); PG8_STAGE(PG8_SB(1, 1), b3 + hstepB, voffB); PG8_STAGE(PG8_SA(1, 0), a3, voffA);
            PG8_WAIT_V(8); PG8_WAIT_L(0); PG8_BAR; PG8_MMA(1, 0, At, B0); PG8_MMA(1, 1, At, B1); PG8_BAR; PG8_SCHED;
        }
        if constexpr (ALIGN_EPI) { if (wr == 0) PG8_BAR; }
        E(acc, cur, wr, wc, fr, fq);
        if (!has_next) break;
#pragma unroll
        for (int a = 0; a < 2; ++a)
#pragma unroll
            for (int b = 0; b < 2; ++b)
#pragma unroll
                for (int m = 0; m < 4; ++m)
#pragma unroll
                    for (int n = 0; n < 2; ++n) acc[a][b][m][n] = (f32x4){0.f, 0.f, 0.f, 0.f};
        cur = nxt; cA = nA; cB = nB; ++ui;
        if constexpr (ALIGN_EPI) { if (wr == 1) PG8_BAR; }
    }
    PG8_WAIT_V(0);
    if constexpr (!ALIGN_EPI) { if (wr == 0) PG8_BAR; }
    PG8_BAR;
#undef PG8_SA
#undef PG8_SB
#undef PG8_STAGE
#undef PG8_LDA
#undef PG8_LDB
#undef PG8_MMA
#undef PG8_WAIT_V
#undef PG8_WAIT_L
#undef PG8_BAR
#undef PG8_SCHED
}
}

constexpr int NWAVES = 8, NTHREADS = NWAVES * 64;
constexpr int BATCH = 8, SEQ = 4096, DM = 1024, M = BATCH * SEQ;
constexpr int WA = 1152, NA = 4 * WA, HA = 18;
constexpr int NBIN = 1440, NBP = 1536, QL = 256, KVL = 128, RD = 32, HB = 16;
constexpr int QW = HB * 96, KVW = HB * 128, C1N_LD = 512, GATE1_OFF = QL + KVL + RD;
constexpr float LN_EPS = 1e-5f, RMS_EPS = 1e-6f, ALPHA = 1.41421356237309515f, LOG2E = 1.4426950408889634f, LN2 = 0.69314718055994531f;
constexpr float QSCALE_A = 0.125f * LOG2E;
constexpr float QSCALE_B = 0.10206207261596577f * LOG2E;

constexpr size_t MiB = 1u << 20;
constexpr size_t WS_CTL = 0, CTL_ZERO_BYTES = 1 * MiB;
constexpr size_t WS_MOD = 1 * MiB;
constexpr size_t WS_ROPE = 1 * MiB + 512 * 1024;
constexpr size_t WS_WIN0 = 2 * MiB, WS_WOUT0 = 11 * MiB + 256 * 1024, WS_WIN1 = 14 * MiB, WS_WUQ = 17 * MiB, WS_WUKV = 18 * MiB, WS_WOUT1 = 19 * MiB;
constexpr size_t WS_U = 24 * MiB;
constexpr size_t WS_BIG = 88 * MiB;
constexpr size_t WS_QKVG = WS_BIG;
constexpr size_t WS_O0 = WS_BIG + 288 * MiB;
constexpr size_t WS_LSE = WS_O0 + 72 * MiB;
constexpr size_t WS_Z = WS_BIG;
constexpr size_t WS_C1 = WS_BIG;
constexpr size_t WS_Q1 = WS_BIG + 96 * MiB;
constexpr size_t WS_KV1 = WS_BIG + 192 * MiB;
constexpr size_t WS_C1N = WS_BIG + 320 * MiB;
constexpr size_t WS_END = WS_LSE + 3 * MiB;
static_assert(WS_C1N + (size_t)M * C1N_LD * 2 <= WS_END && WS_WOUT0 + (size_t)DM * WA * 2 <= WS_WIN1 && WS_WIN0 + (size_t)NA * DM * 2 <= WS_WOUT0, "ws map");
constexpr int CW_TMO = 0, CW_CODE = 1, CW_ERR = 64, CW_BAR = 4096;

constexpr int RING_BYTES = 143360;
constexpr int LDSCTL_OFF = RING_BYTES, MISC_OFF = LDSCTL_OFF + 320;
constexpr int LDS_BYTES = 147456;

typedef unsigned short bf16;
typedef unsigned v4u __attribute__((ext_vector_type(4)));
typedef unsigned v2u __attribute__((ext_vector_type(2)));
typedef float f32x4 __attribute__((ext_vector_type(4)));
typedef float f32x2 __attribute__((ext_vector_type(2)));
typedef float f32x16 __attribute__((ext_vector_type(16)));
typedef short bf16x8 __attribute__((ext_vector_type(8)));
typedef short s16x4 __attribute__((ext_vector_type(4)));
typedef GAS unsigned gu32;
#define RLX_AGENT __ATOMIC_RELAXED, __HIP_MEMORY_SCOPE_AGENT
#define LDS_WAIT() asm volatile("s_waitcnt lgkmcnt(0)" ::: "memory")
#define VM_WAIT() asm volatile("s_waitcnt vmcnt(0)" ::: "memory")
__device__ __forceinline__ unsigned f2bf(float f) { unsigned u = __builtin_bit_cast(unsigned, f); return (u + 0x7fffu + ((u >> 16) & 1u)) >> 16; }
__device__ __forceinline__ unsigned pk2(float lo, float hi) { return f2bf(lo) | (f2bf(hi) << 16); }
__device__ __forceinline__ float bflo(unsigned w) { return __uint_as_float(w << 16); }
__device__ __forceinline__ float bfhi(unsigned w) { return __uint_as_float(w & 0xffff0000u); }
__device__ __forceinline__ float bf2f(bf16 h) { return __uint_as_float(((unsigned)h) << 16); }
__device__ __forceinline__ float silu_f(float v) { return v / (1.0f + __expf(-v)); }
__device__ __forceinline__ int crow(int r, int hi) { return (r & 3) + 8 * (r >> 2) + 4 * hi; }

#define XB_TMO      128
#define XB_XCNT(j)  (256  + 64 * (j))
#define XB_XSUB(j)  (1280 + 64 * (j))
#define XB_XGEN(j)  (2304 + 64 * (j))
#define XB_TOP      3328
#define XB_TOPGEN   3392
#define XCD_BAR_WORDS 3456
#define XB_SPIN_CAP (1u << 18)
__device__ __forceinline__ unsigned xb_ld(unsigned* p)              { return __hip_atomic_load(p, __ATOMIC_RELAXED, __HIP_MEMORY_SCOPE_AGENT); }
__device__ __forceinline__ unsigned xb_add(unsigned* p, unsigned v) { return __hip_atomic_fetch_add(p, v, __ATOMIC_RELAXED, __HIP_MEMORY_SCOPE_AGENT); }
__device__ __forceinline__ unsigned xb_xcc_id() { return (unsigned)__builtin_amdgcn_s_getreg((3 << 11) | 20) & 0xFu; }
#define XB_SPIN(cond, bar) do { unsigned _sp = 0; while (cond) { __builtin_amdgcn_s_sleep(1); \
    if ((++_sp & 255u) == 0u) { if (xb_ld(&(bar)[XB_TMO])) break; if (_sp > XB_SPIN_CAP) { atomicAdd(&(bar)[XB_TMO], 1u); break; } } } } while (0)
struct XcdBarrier { unsigned* bar; unsigned x; volatile LAS unsigned* st; };
__device__ __forceinline__ XcdBarrier xcd_barrier_post(unsigned* bar, volatile LAS unsigned* st) {
    XcdBarrier b; b.bar = bar; b.x = xb_xcc_id(); b.st = st;
    if (threadIdx.x == 0) (void)xb_add(&bar[XB_XCNT(b.x)], 1u);
    return b;
}
__device__ __forceinline__ void xcd_barrier_complete(unsigned* bar, unsigned x, unsigned& nloc, unsigned& nx) {
    const unsigned G = gridDim.x * gridDim.y * gridDim.z;
    unsigned sum, cnt, mine, sp = 0u;
    for (;;) {
        sum = 0u; cnt = 0u; mine = 0u;
#pragma unroll
        for (unsigned j = 0; j < 16; ++j) { const unsigned c = xb_ld(&bar[XB_XCNT(j)]); sum += c; cnt += (c > 0u) ? 1u : 0u; mine = (j == x) ? c : mine; }
        if (sum == G) break;
        __builtin_amdgcn_s_sleep(1);
        if ((++sp & 255u) == 0u) { if (xb_ld(&bar[XB_TMO])) break; if (sp > XB_SPIN_CAP) { atomicAdd(&bar[XB_TMO], 1u); break; } }
    }
    nloc = mine > 0u ? mine : 1u; nx = cnt > 0u ? cnt : 1u;
}
__device__ __forceinline__ void xcd_barrier(const XcdBarrier& b) {
    asm volatile("s_waitcnt vmcnt(0)" ::: "memory");
    __syncthreads();
    if (threadIdx.x == 0) {
        unsigned* bar = b.bar;
        __builtin_amdgcn_s_waitcnt(0);
        unsigned nloc = b.st[0], nx = b.st[1];
        if (nloc == 0u) { xcd_barrier_complete(bar, b.x, nloc, nx); b.st[0] = nloc; b.st[1] = nx; }
        const unsigned old = xb_add(&bar[XB_XSUB(b.x)], 1u);
        const unsigned gen = old / nloc;
        if (old + 1u == (gen + 1u) * nloc) {
            __builtin_amdgcn_fence(__ATOMIC_RELEASE, "agent");
            asm volatile("s_waitcnt vmcnt(0)" ::: "memory");
            const unsigned og = xb_add(&bar[XB_TOP], 1u);
            const unsigned tg = og / nx;
            if (og + 1u == (tg + 1u) * nx) xb_add(&bar[XB_TOPGEN], 1u);
            else XB_SPIN(xb_ld(&bar[XB_TOPGEN]) == tg, bar);
            __builtin_amdgcn_fence(__ATOMIC_ACQUIRE, "agent");
            xb_add(&bar[XB_XGEN(b.x)], 1u);
            asm volatile("s_waitcnt vmcnt(0)" ::: "memory");
        } else {
            XB_SPIN(xb_ld(&bar[XB_XGEN(b.x)]) == gen, bar);
            __builtin_amdgcn_fence(__ATOMIC_ACQUIRE, "agent");
            asm volatile("s_waitcnt vmcnt(0)" ::: "memory");
        }
    }
    __syncthreads();
}

struct Frame {
    LAS unsigned char* lds;
    int tid, lane, wave, vcu, G;
    const float *x, *c, *rel_bias, *ada_w, *ada_b, *ln_g, *ln_b, *a_w_in, *a_w_out, *b_w_in, *b_q_norm, *b_w_uq, *b_kv_norm, *b_w_ukv, *b_w_out;
    float* out; unsigned char* ws;
};
__device__ __forceinline__ float wave_sum(float v) {
#pragma unroll
    for (int o = 1; o < 64; o <<= 1) v += __shfl_xor(v, o);
    return v;
}

__device__ __forceinline__ void p0_transpose_item(const float* W, int K, int N, bf16* WT, int ldt, LAS float* scr, int item, int lane, float scale_lo, int nsplit, const float* rowscale) {
    const int nblk = N / 32, kb = item / nblk, nb = item % nblk, k0 = 64 * kb, n0 = 32 * nb;
    const float sc = (n0 < nsplit) ? scale_lo : 1.0f;
#pragma unroll 8
    for (int i = 0; i < 32; ++i) { const int kk = 2 * i + (lane >> 5); const float rs = rowscale ? rowscale[k0 + kk] : 1.0f; scr[kk * 33 + (lane & 31)] = W[(size_t)(k0 + kk) * N + n0 + (lane & 31)] * (sc * rs); }
    LDS_WAIT(); asm volatile("" ::: "memory");
    const int c = lane & 7;
#pragma unroll
    for (int j = 0; j < 4; ++j) { const int n = (lane >> 3) + 8 * j; const LAS float* s = scr + (8 * c) * 33 + n;
        v4u o; o.x = pk2(s[0 * 33], s[1 * 33]); o.y = pk2(s[2 * 33], s[3 * 33]); o.z = pk2(s[4 * 33], s[5 * 33]); o.w = pk2(s[6 * 33], s[7 * 33]);
        *(GAS v4u*)(WT + (size_t)(n0 + n) * ldt + k0 + 8 * c) = o; }
    LDS_WAIT(); asm volatile("" ::: "memory");
}
__device__ __forceinline__ void p0_prologue(Frame& F) {
    if (F.vcu < 96) {
        LAS float* sc = (LAS float*)F.lds;
        LAS float* red = (LAS float*)(F.lds + 32768);
        for (int idx = F.tid; idx < 8 * 1024; idx += NTHREADS) sc[idx] = silu_f(F.c[idx]);
        __syncthreads();
        const int i = F.vcu / 48, nb = F.vcu % 48, n = nb * 64 + F.lane, k0 = F.wave * 128;
        const float* W = F.ada_w + (size_t)i * DM * 3 * DM + n;
        float acc[8];
#pragma unroll
        for (int b = 0; b < 8; ++b) acc[b] = 0.f;
#pragma unroll 8
        for (int kk = 0; kk < 128; ++kk) { const float w = W[(size_t)(k0 + kk) * (3 * DM)];
#pragma unroll
            for (int b = 0; b < 8; ++b) acc[b] += sc[b * 1024 + k0 + kk] * w; }
#pragma unroll
        for (int b = 0; b < 8; ++b) red[(F.wave * 8 + b) * 64 + F.lane] = acc[b];
        __syncthreads();
        { const int b = F.tid >> 6; float s = 0.f;
#pragma unroll
          for (int w = 0; w < 8; ++w) s += red[(w * 8 + b) * 64 + F.lane];
          ((float*)(F.ws + WS_MOD))[(size_t)(i * 8 + b) * (3 * DM) + n] = s + F.ada_b[i * 3 * DM + n]; }
        __syncthreads();
    }
    LAS float* scr = (LAS float*)(F.lds + F.wave * 16384);
    const int gw = F.vcu * NWAVES + F.wave, NGW = F.G * NWAVES;
    constexpr int I0 = (DM / 64) * (NA / 32), I1 = (WA / 64) * (DM / 32), I2 = (DM / 64) * (NBIN / 32), I3 = (QL / 64) * (QW / 32), I4 = (KVL / 64) * (KVW / 32), I5 = (DM / 64) * (DM / 32);
    constexpr int NITEMS = I0 + I1 + I2 + I3 + I4 + I5;
    for (int it = gw; it < NITEMS; it += NGW) {
        int r = it;
        if (r < I0) { p0_transpose_item(F.a_w_in, DM, NA, (bf16*)(F.ws + WS_WIN0), DM, scr, r, F.lane, QSCALE_A, WA, nullptr); continue; } r -= I0;
        if (r < I1) { p0_transpose_item(F.a_w_out, WA, DM, (bf16*)(F.ws + WS_WOUT0), WA, scr, r, F.lane, 1.f, 0, nullptr); continue; } r -= I1;
        if (r < I2) { p0_transpose_item(F.b_w_in, DM, NBIN, (bf16*)(F.ws + WS_WIN1), DM, scr, r, F.lane, 1.f, 0, nullptr); continue; } r -= I2;
        if (r < I3) { p0_transpose_item(F.b_w_uq, QL, QW, (bf16*)(F.ws + WS_WUQ), QL, scr, r, F.lane, QSCALE_B, QW, F.b_q_norm); continue; } r -= I3;
        if (r < I4) { p0_transpose_item(F.b_w_ukv, KVL, KVW, (bf16*)(F.ws + WS_WUKV), 256, scr, r, F.lane, 1.f, 0, F.b_kv_norm); continue; } r -= I4;
        p0_transpose_item(F.b_w_out, DM, DM, (bf16*)(F.ws + WS_WOUT1), DM, scr, r, F.lane, 1.f, 0, nullptr);
    }
    { const int gt = F.vcu * NTHREADS + F.tid, NGT = F.G * NTHREADS; const v4u z = {0u, 0u, 0u, 0u};
      for (int i = gt; i < (NBP - NBIN) * DM / 8; i += NGT) *(GAS v4u*)((bf16*)(F.ws + WS_WIN1) + (size_t)NBIN * DM + (size_t)i * 8) = z;
      for (int i = gt; i < KVW * 16; i += NGT) { const int n = i >> 4, cch = i & 15; *(GAS v4u*)((bf16*)(F.ws + WS_WUKV) + (size_t)n * 256 + 128 + cch * 8) = z; }
      for (int i = gt; i < SEQ * 16; i += NGT) { const int pos = i >> 4, fi = i & 15; const float inv = powf(10000.0f, -(float)(2 * fi) / 32.0f); const float ang = (float)pos * inv;
          ((f32x2*)(F.ws + WS_ROPE))[i] = (f32x2){cosf(ang), sinf(ang)}; } }
}

__device__ __forceinline__ void p0b_modulate(Frame& F) {
    const int gw = F.vcu * NWAVES + F.wave, NGW = F.G * NWAVES, RPW = (M + NGW - 1) / NGW;
    const float* mod = (const float*)(F.ws + WS_MOD);
    for (int m0 = gw * RPW; m0 < min(M, (gw + 1) * RPW); ) {
        const int b = m0 / SEQ, mend = min(min(M, (gw + 1) * RPW), (b + 1) * SEQ);
        const f32x4* sh = (const f32x4*)(mod + (size_t)b * 3 * DM) + F.lane; const f32x4* scp = (const f32x4*)(mod + (size_t)b * 3 * DM + DM) + F.lane;
        f32x4 shv[4], scv[4];
#pragma unroll
        for (int j = 0; j < 4; ++j) { shv[j] = sh[64 * j]; scv[j] = scp[64 * j] + 1.0f; }
        for (int m = m0; m < mend; ++m) {
            const GAS f32x4* xr = (const GAS f32x4*)(F.x + (size_t)m * DM) + F.lane;
            GAS v2u* o8 = (GAS v2u*)((bf16*)(F.ws + WS_U) + (size_t)m * DM) + F.lane;
            f32x4 v[4];
#pragma unroll
            for (int j = 0; j < 4; ++j) v[j] = xr[64 * j];
#pragma unroll
            for (int j = 0; j < 4; ++j) { const f32x4 u = v[j] * scv[j] + shv[j]; o8[64 * j] = (v2u){pk2(u.x, u.y), pk2(u.z, u.w)}; }
        }
        m0 = mend;
    }
}

namespace dil {
constexpr int KROWS = 384, KPLANE = KROWS * 16 + 16, VPLANE = KROWS * 64 + 64;
constexpr int L_K = 0, L_V = 8 * KPLANE, L_BIAS = L_V + 2 * VPLANE, L_WS = L_BIAS + 768, L_OST = L_WS + NWAVES * 256, L_END = L_OST + NWAVES * 4096;
static_assert(L_END <= RING_BYTES, "dilated attention LDS");
constexpr int NUNITS = BATCH * HA * 16;
__device__ __forceinline__ int t5_bucket(int rel) {
    const int base = rel > 0 ? 16 : 0; const int n = rel < 0 ? -rel : rel; const float nf = (float)(n > 1 ? n : 1);
    int large = 8 + (int)(logf(nf / 8.0f) / 4.852030263919617f * 8.0f); large = large < 15 ? large : 15;
    return base + (n < 8 ? n : large);
}
__device__ __forceinline__ void unit(Frame& F, int u) {
    const int blk = u & 15, h = (u >> 4) % HA, b = u / (16 * HA), g = h / 6;
    const int d = (g == 0) ? 1 : (g == 1 ? 4 : 16), L = SEQ / d, nblk = L / 256;
    const int rcls = blk / nblk, jb = blk % nblk, jstart = 256 * jb - 64;
    const bf16* QKVG = (const bf16*)(F.ws + WS_QKVG);
    LAS unsigned char* lds = F.lds; const int tid = F.tid, lane = F.lane, wid = F.wave, r32 = lane & 31, hi = lane >> 5;
    {   v4u kv[6], vv[6];
#pragma unroll
        for (int i = 0; i < 6; ++i) { const int p = tid + i * NTHREADS, row = p >> 3, c = p & 7, j = jstart + row; const bool ok = (j >= 0 && j < L);
            const size_t grow = (size_t)b * SEQ + rcls + (size_t)d * (ok ? j : 0);
            const GAS v4u* src = (const GAS v4u*)(QKVG + grow * NA + WA + h * 64 + c * 8);
            kv[i] = ok ? src[0] : (v4u){0u, 0u, 0u, 0u}; vv[i] = ok ? src[WA / 8] : (v4u){0u, 0u, 0u, 0u}; }
#pragma unroll
        for (int i = 0; i < 6; ++i) { const int p = tid + i * NTHREADS, row = p >> 3, c = p & 7;
            *(LAS v4u*)(lds + L_K + c * KPLANE + row * 16) = kv[i];
            *(LAS v4u*)(lds + L_V + (c >> 2) * VPLANE + row * 64 + (c & 3) * 16) = vv[i]; }
        if (tid < 192) { const int off = tid - 95; const int ao = off < 0 ? -off : off;
            ((LAS float*)(lds + L_BIAS))[tid] = (ao <= 64) ? F.rel_bias[t5_bucket(off * d) * HA + h] * LOG2E : -1e30f; }
    }
    const int jq = 256 * jb + 32 * wid + r32; const size_t growq = (size_t)b * SEQ + rcls + (size_t)d * jq;
    bf16x8 qr[4];
#pragma unroll
    for (int d0 = 0; d0 < 4; ++d0) qr[d0] = *(const GAS bf16x8*)(QKVG + growq * NA + h * 64 + d0 * 16 + hi * 8);
    __syncthreads();
    f32x16 s[5];
#pragma unroll
    for (int i = 0; i < 5; ++i) {
        s[i] = (f32x16){0};
#pragma unroll
        for (int d0 = 0; d0 < 4; ++d0) { const bf16x8 a = *(const LAS bf16x8*)(lds + L_K + (2 * d0 + hi) * KPLANE + (32 * wid + 32 * i + r32) * 16);
            s[i] = __builtin_amdgcn_mfma_f32_32x32x16_bf16(a, qr[d0], s[i], 0, 0, 0); }
    }
    const LAS float* biasl = (const LAS float*)(lds + L_BIAS);
    const int jk0 = jstart + 32 * wid + 4 * hi; float mx = -3.0e38f;
#pragma unroll
    for (int i = 0; i < 5; ++i)
#pragma unroll
        for (int r = 0; r < 16; ++r) { const int kk = 32 * i + (r & 3) + 8 * (r >> 2); const int jk = jk0 + kk; const int idx = kk + 4 * hi - r32 + 31;
            float v = s[i][r] + biasl[idx]; v = (jk >= 0 && jk < L) ? v : -1e30f; s[i][r] = v; mx = fmaxf(mx, v); }
    mx = fmaxf(mx, __shfl_xor(mx, 32));
    float l = 0.f;
#pragma unroll
    for (int i = 0; i < 5; ++i)
#pragma unroll
        for (int r = 0; r < 16; ++r) { const float p = __builtin_amdgcn_exp2f(s[i][r] - mx); s[i][r] = p; l += p; }
    l += __shfl_xor(l, 32);
    f32x16 o[2]; o[0] = (f32x16){0}; o[1] = (f32x16){0};
    const int vlane = ((lane >> 4) & 1) * 32 + (lane & 3) * 8 + (4 * hi + ((lane & 15) >> 2)) * 64;
#pragma unroll
    for (int i = 0; i < 5; ++i)
#pragma unroll
        for (int ks = 0; ks < 2; ++ks) {
            v4u pw; pw.x = pg8::cvt_pk_bf16(s[i][8 * ks + 0], s[i][8 * ks + 1]); pw.y = pg8::cvt_pk_bf16(s[i][8 * ks + 2], s[i][8 * ks + 3]);
            pw.z = pg8::cvt_pk_bf16(s[i][8 * ks + 4], s[i][8 * ks + 5]); pw.w = pg8::cvt_pk_bf16(s[i][8 * ks + 6], s[i][8 * ks + 7]);
            const bf16x8 pa = __builtin_bit_cast(bf16x8, pw);
#pragma unroll
            for (int d0 = 0; d0 < 2; ++d0) { LAS unsigned char* vp = lds + L_V + d0 * VPLANE + (32 * wid + 32 * i + 16 * ks) * 64 + vlane;
                const s16x4 lo = __builtin_bit_cast(s16x4, __builtin_amdgcn_ds_read_tr16_b64_v4i16((LAS s16x4*)vp));
                const s16x4 hh = __builtin_bit_cast(s16x4, __builtin_amdgcn_ds_read_tr16_b64_v4i16((LAS s16x4*)(vp + 512)));
                const bf16x8 vf = (bf16x8){lo[0], lo[1], lo[2], lo[3], hh[0], hh[1], hh[2], hh[3]};
                o[d0] = __builtin_amdgcn_mfma_f32_32x32x16_bf16(pa, vf, o[d0], 0, 0, 0); }
        }
    LAS float* wsf = (LAS float*)(lds + L_WS) + wid * 64;
    if (hi == 0) { wsf[r32] = 1.0f / l; ((float*)(F.ws + WS_LSE))[growq * HA + h] = (mx + __builtin_amdgcn_logf(l)) * LN2; }
    LDS_WAIT();
    LAS bf16* stg = (LAS bf16*)(lds + L_OST) + wid * 2048;
#pragma unroll
    for (int r = 0; r < 16; ++r) { const int orow = crow(r, hi); const float rl = wsf[orow];
#pragma unroll
        for (int d0 = 0; d0 < 2; ++d0) stg[orow * 64 + d0 * 32 + r32] = (bf16)f2bf(o[d0][r] * rl); }
    LDS_WAIT();
    bf16* O0 = (bf16*)(F.ws + WS_O0);
#pragma unroll
    for (int i = 0; i < 4; ++i) { const int row = i * 8 + (lane >> 3), ch = lane & 7; const v4u v = *(const LAS v4u*)(stg + row * 64 + ch * 8);
        const size_t grow = (size_t)b * SEQ + rcls + (size_t)d * (256 * jb + 32 * wid + row);
        *(GAS v4u*)(O0 + grow * WA + h * 64 + ch * 8) = v; }
    __syncthreads();
}
}

__device__ __forceinline__ void p2b_combine(Frame& F) {
    const int gt = F.vcu * NTHREADS + F.tid, NGT = F.G * NTHREADS;
    const bf16* QKVG = (const bf16*)(F.ws + WS_QKVG); bf16* O0 = (bf16*)(F.ws + WS_O0); const float* LSE = (const float*)(F.ws + WS_LSE);
    for (int cidx = gt; cidx < M * (WA / 8); cidx += NGT) {
        const int row = cidx / (WA / 8), hc = cidx % (WA / 8), head = hc >> 3, hg = head % 6, g = head / 6;
        const float l0 = LSE[(size_t)row * HA + hg], l1 = LSE[(size_t)row * HA + 6 + hg], l2 = LSE[(size_t)row * HA + 12 + hg];
        const float mxl = fmaxf(l0, fmaxf(l1, l2)); const float e0 = __expf(l0 - mxl), e1 = __expf(l1 - mxl), e2 = __expf(l2 - mxl);
        const float w = (g == 0 ? e0 : (g == 1 ? e1 : e2)) / (e0 + e1 + e2);
        const v4u ov = *(const GAS v4u*)(O0 + (size_t)row * WA + hc * 8); const v4u gv = *(const GAS v4u*)(QKVG + (size_t)row * NA + 3 * WA + hc * 8);
        v4u r;
#pragma unroll
        for (int k = 0; k < 4; ++k) { const float a = bflo(ov[k]) * w * silu_f(bflo(gv[k])), bb = bfhi(ov[k]) * w * silu_f(bfhi(gv[k])); r[k] = pk2(a, bb); }
        *(GAS v4u*)(O0 + (size_t)row * WA + hc * 8) = r;
    }
}

template <bool WITH_U>
__device__ __forceinline__ void ln_pass(Frame& F, const float* xin, const bf16* Z, float* xout, int layer, bf16* U) {
    const int gw = F.vcu * NWAVES + F.wave, NGW = F.G * NWAVES, RPW = (M + NGW - 1) / NGW;
    const float* mod = (const float*)(F.ws + WS_MOD);
    for (int m0 = gw * RPW; m0 < min(M, (gw + 1) * RPW); ) {
        const int b = m0 / SEQ, mend = min(min(M, (gw + 1) * RPW), (b + 1) * SEQ);
        f32x4 gt[4], lg[4], lb[4];
#pragma unroll
        for (int j = 0; j < 4; ++j) { gt[j] = ((const f32x4*)(mod + (size_t)(layer * 8 + b) * 3 * DM + 2 * DM))[F.lane + 64 * j];
            lg[j] = ((const f32x4*)(F.ln_g + layer * DM))[F.lane + 64 * j]; lb[j] = ((const f32x4*)(F.ln_b + layer * DM))[F.lane + 64 * j]; }
        for (int m = m0; m < mend; ++m) {
            const GAS f32x4* xr = (const GAS f32x4*)(xin + (size_t)m * DM) + F.lane; const GAS v2u* zr = (const GAS v2u*)(Z + (size_t)m * DM) + F.lane;
            f32x4 v[4]; float s = 0.f;
#pragma unroll
            for (int j = 0; j < 4; ++j) { const f32x4 xv = xr[64 * j]; const v2u zv = zr[64 * j]; const f32x4 zf = (f32x4){bflo(zv.x), bfhi(zv.x), bflo(zv.y), bfhi(zv.y)};
                v[j] = xv * ALPHA + gt[j] * zf; s += (v[j].x + v[j].y) + (v[j].z + v[j].w); }
            const float mean = wave_sum(s) * (1.f / DM); float s2 = 0.f;
#pragma unroll
            for (int j = 0; j < 4; ++j) { v[j] = v[j] - mean; s2 += (v[j].x * v[j].x + v[j].y * v[j].y) + (v[j].z * v[j].z + v[j].w * v[j].w); }
            const float rstd = 1.f / sqrtf(wave_sum(s2) * (1.f / DM) + LN_EPS);
            GAS f32x4* orow = (GAS f32x4*)(xout + (size_t)m * DM) + F.lane;
#pragma unroll
            for (int j = 0; j < 4; ++j) { v[j] = v[j] * rstd * lg[j] + lb[j]; orow[64 * j] = v[j]; }
            if constexpr (WITH_U) {
                GAS v2u* u8 = (GAS v2u*)(U + (size_t)m * DM) + F.lane;
#pragma unroll
                for (int j = 0; j < 4; ++j) { const f32x4 sh = ((const f32x4*)(mod + (size_t)((layer + 1) * 8 + b) * 3 * DM))[F.lane + 64 * j];
                    const f32x4 sc = ((const f32x4*)(mod + (size_t)((layer + 1) * 8 + b) * 3 * DM + DM))[F.lane + 64 * j];
                    const f32x4 u = v[j] * (sc + 1.0f) + sh; u8[64 * j] = (v2u){pk2(u.x, u.y), pk2(u.z, u.w)}; }
            }
        }
        m0 = mend;
    }
}

__device__ __forceinline__ void p4b_norm_rope(Frame& F) {
    const int gw = F.vcu * NWAVES + F.wave, NGW = F.G * NWAVES;
    const bf16* C1 = (const bf16*)(F.ws + WS_C1); bf16* C1N = (bf16*)(F.ws + WS_C1N); const f32x2* CS = (const f32x2*)(F.ws + WS_ROPE);
    for (int m = gw; m < M; m += NGW) {
        const bf16* row = C1 + (size_t)m * NBP; bf16* orow = C1N + (size_t)m * C1N_LD; const int l = F.lane;
        const v2u q4 = *(const GAS v2u*)(row + 4 * l); const unsigned k2 = *(const GAS unsigned*)(row + QL + 2 * l);
        const float q0 = bflo(q4.x), q1 = bfhi(q4.x), q2 = bflo(q4.y), q3 = bfhi(q4.y), k0 = bflo(k2), k1 = bfhi(k2);
        const float rq = 1.0f / sqrtf(wave_sum(q0 * q0 + q1 * q1 + q2 * q2 + q3 * q3) * (1.0f / QL) + RMS_EPS);
        const float rk = 1.0f / sqrtf(wave_sum(k0 * k0 + k1 * k1) * (1.0f / KVL) + RMS_EPS);
        *(GAS v2u*)(orow + 4 * l) = (v2u){pk2(q0 * rq, q1 * rq), pk2(q2 * rq, q3 * rq)};
        *(GAS unsigned*)(orow + QL + 2 * l) = pk2(k0 * rk, k1 * rk);
        if (l < 16) { const float x1 = bf2f(row[QL + KVL + l]), x2 = bf2f(row[QL + KVL + 16 + l]); const f32x2 cs = CS[(m % SEQ) * 16 + l];
            orow[QL + KVL + l] = (bf16)f2bf(x1 * cs.x - x2 * cs.y); orow[QL + KVL + 16 + l] = (bf16)f2bf(x2 * cs.x + x1 * cs.y); }
        else if (l < 64) { *(GAS unsigned*)(orow + GATE1_OFF + 2 * (l - 16)) = 0u; }
    }
}

namespace mla {
constexpr int KVBLK = 64, NT = SEQ / KVBLK, KSLOT = 12288, VSLOT = 8192;
constexpr int L_K = 0, L_V = 3 * KSLOT, L_WS = L_V + 3 * VSLOT, L_OST = L_WS + NWAVES * 256, L_END = L_OST + NWAVES * 4096;
static_assert(L_END <= RING_BYTES, "mla LDS");
constexpr int NUNITS = BATCH * HB * (SEQ / 256);
constexpr float THR = 8.0f;
__device__ __forceinline__ void glds16(const void* gsrc, unsigned lds_dst) { unsigned keep;
    asm volatile("s_mov_b32 %0, m0\n\ts_mov_b32 m0, %2\n\ts_nop 0\n\tglobal_load_lds_dwordx4 %1, off\n\ts_mov_b32 m0, %0" : "=&s"(keep) : "v"(gsrc), "s"(lds_dst) : "memory"); }
__device__ __forceinline__ void unit(Frame& F, int b, int h, int qb) {
    LAS unsigned char* lds = F.lds; const int lane = F.lane, wid = F.wave, r32 = lane & 31, hi = lane >> 5;
    const size_t rowbase = (size_t)b * SEQ; const int q0 = qb * 256;
    const bf16* KV1 = (const bf16*)(F.ws + WS_KV1); const bf16* C1N = (const bf16*)(F.ws + WS_C1N); const bf16* Q1 = (const bf16*)(F.ws + WS_Q1); const bf16* C1 = (const bf16*)(F.ws + WS_C1);
    const bf16* ksrc = KV1 + (rowbase + lane) * KVW + h * 128 + wid * 8;
    const bf16* krsrc = C1N + (rowbase + lane) * C1N_LD + QL + KVL + (wid & 3) * 8;
    const bf16* vsrc = KV1 + (rowbase + 16 * (wid & 3) + (lane >> 2)) * KVW + h * 128 + 64 + (wid >> 2) * 32 + (lane & 3) * 8;
    const unsigned lds0 = (unsigned)(uintptr_t)lds;
    const unsigned kdst = lds0 + L_K + wid * 1024, krdst = lds0 + L_K + (8 + (wid & 3)) * 1024, vdst = lds0 + L_V + wid * 1024;
    const bool w4 = wid < 4;
#define MLA_DMA(t, sk, sv) do { glds16(ksrc + (size_t)(t) * KVBLK * KVW, (unsigned)__builtin_amdgcn_readfirstlane(kdst + (sk))); \
        if (w4) glds16(krsrc + (size_t)(t) * KVBLK * C1N_LD, (unsigned)__builtin_amdgcn_readfirstlane(krdst + (sk))); \
        glds16(vsrc + (size_t)(t) * KVBLK * KVW, (unsigned)__builtin_amdgcn_readfirstlane(vdst + (sv))); } while (0)
    MLA_DMA(0, 0, 0); MLA_DMA(1, KSLOT, VSLOT);
    const bf16* qrow = Q1 + (rowbase + q0 + wid * 32 + r32) * QW + h * 96;
    bf16x8 qr[6];
#pragma unroll
    for (int d0 = 0; d0 < 6; ++d0) qr[d0] = *(const GAS bf16x8*)(qrow + d0 * 16 + hi * 8);
    { const f32x4* cs = (const f32x4*)((const f32x2*)(F.ws + WS_ROPE) + (size_t)(q0 + wid * 32 + r32) * 16 + 8 * hi);
      v4u a = __builtin_bit_cast(v4u, qr[4]), c2 = __builtin_bit_cast(v4u, qr[5]);
#pragma unroll
      for (int k = 0; k < 4; ++k) { const f32x4 cc = cs[k];
          const float x1a = bflo(a[k]), x1b = bfhi(a[k]), x2a = bflo(c2[k]), x2b = bfhi(c2[k]);
          a[k] = pk2(x1a * cc.x - x2a * cc.y, x1b * cc.z - x2b * cc.w); c2[k] = pk2(x2a * cc.x + x1a * cc.y, x2b * cc.z + x1b * cc.w); }
      qr[4] = __builtin_bit_cast(bf16x8, a); qr[5] = __builtin_bit_cast(bf16x8, c2); }
    float mref = -1e30f, l = 0.f; f32x16 o[2]; o[0] = (f32x16){0}; o[1] = (f32x16){0};
    LAS float* wsf = (LAS float*)(lds + L_WS) + wid * 64;
    const int vlane = ((lane >> 4) & 1) * 32 + (lane & 3) * 8 + (4 * hi + ((lane & 15) >> 2)) * 64;
    int sk = 0, sv = 0, sk2 = 2 * KSLOT, sv2 = 2 * VSLOT;
    for (int t = 0; t < NT; ++t) {
        if (t + 1 < NT) { if (w4) asm volatile("s_waitcnt vmcnt(3) lgkmcnt(0)\n\ts_barrier" ::: "memory"); else asm volatile("s_waitcnt vmcnt(2) lgkmcnt(0)\n\ts_barrier" ::: "memory"); }
        else asm volatile("s_waitcnt vmcnt(0) lgkmcnt(0)\n\ts_barrier" ::: "memory");
        if (t + 2 < NT) MLA_DMA(t + 2, sk2, sv2);
        f32x16 p0 = (f32x16){0}, p1 = (f32x16){0};
        LAS unsigned char* kb = lds + L_K + sk + hi * 1024 + r32 * 16;
#pragma unroll
        for (int d0 = 0; d0 < 6; ++d0) { const bf16x8 a0 = *(const LAS bf16x8*)(kb + d0 * 2048), a1 = *(const LAS bf16x8*)(kb + d0 * 2048 + 512);
            p0 = __builtin_amdgcn_mfma_f32_32x32x16_bf16(a0, qr[d0], p0, 0, 0, 0); p1 = __builtin_amdgcn_mfma_f32_32x32x16_bf16(a1, qr[d0], p1, 0, 0, 0); }
        float rm = fmaxf(p0[0], p1[0]);
#pragma unroll
        for (int r = 1; r < 16; ++r) rm = fmaxf(rm, fmaxf(p0[r], p1[r]));
        rm = fmaxf(rm, __shfl_xor(rm, 32));
        if (__any(rm > mref + THR)) {
            const float mn = fmaxf(mref, rm), f = __builtin_amdgcn_exp2f(mref - mn); mref = mn; l *= f;
            if (hi == 0) wsf[r32] = f;
            LDS_WAIT();
#pragma unroll
            for (int r = 0; r < 16; ++r) { const float fr_ = wsf[crow(r, hi)]; o[0][r] *= fr_; o[1][r] *= fr_; }
        }
        float ls = 0.f;
#pragma unroll
        for (int r = 0; r < 16; ++r) { p0[r] = __builtin_amdgcn_exp2f(p0[r] - mref); p1[r] = __builtin_amdgcn_exp2f(p1[r] - mref); ls += p0[r] + p1[r]; }
        l += ls;
        v4u pw[4];
#pragma unroll
        for (int k = 0; k < 4; ++k) { pw[0][k] = pg8::cvt_pk_bf16(p0[2 * k], p0[2 * k + 1]); pw[1][k] = pg8::cvt_pk_bf16(p0[8 + 2 * k], p0[8 + 2 * k + 1]);
            pw[2][k] = pg8::cvt_pk_bf16(p1[2 * k], p1[2 * k + 1]); pw[3][k] = pg8::cvt_pk_bf16(p1[8 + 2 * k], p1[8 + 2 * k + 1]); }
#pragma unroll
        for (int d0 = 0; d0 < 2; ++d0)
#pragma unroll
            for (int ks = 0; ks < 4; ++ks) { LAS unsigned char* vp = lds + L_V + sv + d0 * 4096 + ks * 1024 + vlane;
                const s16x4 lo = __builtin_bit_cast(s16x4, __builtin_amdgcn_ds_read_tr16_b64_v4i16((LAS s16x4*)vp));
                const s16x4 hh = __builtin_bit_cast(s16x4, __builtin_amdgcn_ds_read_tr16_b64_v4i16((LAS s16x4*)(vp + 512)));
                const bf16x8 vf = (bf16x8){lo[0], lo[1], lo[2], lo[3], hh[0], hh[1], hh[2], hh[3]};
                o[d0] = __builtin_amdgcn_mfma_f32_32x32x16_bf16(__builtin_bit_cast(bf16x8, pw[ks]), vf, o[d0], 0, 0, 0); }
        { const int nk = sk + KSLOT, nv = sv + VSLOT; sk2 = sk; sv2 = sv; sk = (nk == 3 * KSLOT) ? 0 : nk; sv = (nv == 3 * VSLOT) ? 0 : nv; }
    }
#undef MLA_DMA
    l += __shfl_xor(l, 32);
    if (hi == 0) wsf[32 + r32] = 1.0f / l;
    LDS_WAIT();
    LAS bf16* stg = (LAS bf16*)(lds + L_OST) + wid * 2048;
#pragma unroll
    for (int r = 0; r < 16; ++r) { const int orow = crow(r, hi); const float rl = wsf[32 + orow];
#pragma unroll
        for (int d0 = 0; d0 < 2; ++d0) stg[orow * 64 + d0 * 32 + r32] = (bf16)f2bf(o[d0][r] * rl); }
    LDS_WAIT();
    bf16* Y1 = (bf16*)(F.ws + WS_U);
#pragma unroll
    for (int i = 0; i < 4; ++i) { const int row = i * 8 + (lane >> 3), ch = lane & 7; const v4u ov = *(const LAS v4u*)(stg + row * 64 + ch * 8);
        const size_t grow = rowbase + q0 + wid * 32 + row; const v4u gv = *(const GAS v4u*)(C1 + grow * NBP + GATE1_OFF + h * 64 + ch * 8);
        v4u rr;
#pragma unroll
        for (int k = 0; k < 4; ++k) rr[k] = pk2(bflo(ov[k]) * silu_f(bflo(gv[k])), bfhi(ov[k]) * silu_f(bfhi(gv[k])));
        *(GAS v4u*)(Y1 + grow * DM + h * 64 + ch * 8) = rr; }
    asm volatile("s_waitcnt vmcnt(0) lgkmcnt(0)\n\ts_barrier" ::: "memory");
}
}

constexpr int NPHASES = 13;
struct Args { const float* in[15]; float* out; unsigned char* ws; int ph_lo, ph_hi; };
__global__ void __launch_bounds__(NTHREADS, 2) fwd_kernel(Args args) {
    extern __shared__ __attribute__((aligned(16))) unsigned char lds_raw[];
    Frame F;
    F.lds = (LAS unsigned char*)lds_raw;
    F.tid = threadIdx.x; F.lane = F.tid & 63; F.wave = __builtin_amdgcn_readfirstlane(F.tid >> 6);
    F.G = gridDim.x; { const int bx = blockIdx.x; F.vcu = (F.G % 8 == 0) ? (bx % 8) * (F.G / 8) + bx / 8 : bx; }
    F.x = args.in[0]; F.c = args.in[1]; F.rel_bias = args.in[2]; F.ada_w = args.in[3]; F.ada_b = args.in[4]; F.ln_g = args.in[5]; F.ln_b = args.in[6];
    F.a_w_in = args.in[7]; F.a_w_out = args.in[8]; F.b_w_in = args.in[9]; F.b_q_norm = args.in[10]; F.b_w_uq = args.in[11]; F.b_kv_norm = args.in[12]; F.b_w_ukv = args.in[13]; F.b_w_out = args.in[14];
    F.out = args.out; F.ws = args.ws;
    volatile LAS unsigned* MISC = (volatile LAS unsigned*)(F.lds + MISC_OFF);
    for (int u = F.tid; u < (LDS_BYTES - LDSCTL_OFF) / 4; u += NTHREADS) ((LAS unsigned*)(F.lds + LDSCTL_OFF))[u] = 0u;
    __syncthreads();
    gu32* ctl = (gu32*)(F.ws + WS_CTL);
    const int lo = args.ph_lo, hi = args.ph_hi;
#if MK_PER_PHASE
#define GRID_BAR() do { } while (0)
#else
    XcdBarrier bar = xcd_barrier_post((unsigned*)(ctl + CW_BAR), MISC + 8);
#define GRID_BAR() xcd_barrier(bar)
#endif
#define IN(k) (lo <= (k) && (k) < hi)
#define SEAM(k) do { if (IN(k) && IN((k) + 1)) GRID_BAR(); } while (0)
    (void)MISC; (void)ctl;
    bf16* U = (bf16*)(F.ws + WS_U);
    if (IN(0)) { p0_prologue(F); } SEAM(0);
    if (IN(1)) { p0b_modulate(F); } SEAM(1);
    if (IN(2)) { pg8::Gemm g{U, (const bf16*)(F.ws + WS_WIN0), M, NA, DM, DM}; pg8::StaticOrder S; S.init(M, NA, F.G, (int)blockIdx.x);
        pg8::EpiBf16 E{(bf16*)(F.ws + WS_QKVG), NA}; pg8::gemm_phase<pg8::EpiBf16, pg8::StaticOrder>(F.lds, g, S, E); } SEAM(2);
    if (IN(3)) { for (int u = F.vcu; u < dil::NUNITS; u += F.G) dil::unit(F, u); } SEAM(3);
    if (IN(4)) { p2b_combine(F); } SEAM(4);
    if (IN(5)) { pg8::Gemm g{(const bf16*)(F.ws + WS_O0), (const bf16*)(F.ws + WS_WOUT0), M, DM, WA, WA}; pg8::StaticOrder S; S.init(M, DM, F.G, (int)blockIdx.x);
        pg8::EpiBf16 E{(bf16*)(F.ws + WS_Z), DM}; pg8::gemm_phase<pg8::EpiBf16, pg8::StaticOrder>(F.lds, g, S, E); } SEAM(5);
    if (IN(6)) { ln_pass<true>(F, F.x, (const bf16*)(F.ws + WS_Z), F.out, 0, U); } SEAM(6);
    if (IN(7)) { pg8::Gemm g{U, (const bf16*)(F.ws + WS_WIN1), M, NBP, DM, DM}; pg8::StaticOrder S; S.init(M, NBP, F.G, (int)blockIdx.x);
        pg8::EpiBf16 E{(bf16*)(F.ws + WS_C1), NBP}; pg8::gemm_phase<pg8::EpiBf16, pg8::StaticOrder>(F.lds, g, S, E); } SEAM(7);
    if (IN(8)) { p4b_norm_rope(F); } SEAM(8);
    if (IN(9)) {
        { pg8::Gemm g{(const bf16*)(F.ws + WS_C1N), (const bf16*)(F.ws + WS_WUQ), M, QW, QL, C1N_LD}; pg8::StaticOrder S; S.init(M, QW, F.G, (int)blockIdx.x);
          pg8::EpiBf16 E{(bf16*)(F.ws + WS_Q1), QW}; pg8::gemm_phase<pg8::EpiBf16, pg8::StaticOrder>(F.lds, g, S, E); }
        { pg8::Gemm g{(const bf16*)(F.ws + WS_C1N) + QL, (const bf16*)(F.ws + WS_WUKV), M, KVW, 256, C1N_LD}; pg8::StaticOrder S; S.init(M, KVW, F.G, (int)blockIdx.x);
          pg8::EpiBf16 E{(bf16*)(F.ws + WS_KV1), KVW}; pg8::gemm_phase<pg8::EpiBf16, pg8::StaticOrder>(F.lds, g, S, E); }
    } SEAM(9);
    if (IN(10)) {
        const int xg = F.vcu / 32, cl = F.vcu % 32;
        if (F.G == 256) { for (int i = 0; i < 8; ++i) { const int pair = xg * 16 + i * 2 + (cl >> 4); mla::unit(F, pair / HB, pair % HB, cl & 15); } }
        else { for (int u = F.vcu; u < mla::NUNITS; u += F.G) mla::unit(F, u / (HB * 16), (u / 16) % HB, u & 15); }
    } SEAM(10);
    if (IN(11)) { pg8::Gemm g{U, (const bf16*)(F.ws + WS_WOUT1), M, DM, DM, DM}; pg8::StaticOrder S; S.init(M, DM, F.G, (int)blockIdx.x);
        pg8::EpiBf16 E{(bf16*)(F.ws + WS_Z), DM}; pg8::gemm_phase<pg8::EpiBf16, pg8::StaticOrder>(F.lds, g, S, E); } SEAM(11);
    if (IN(12)) { ln_pass<false>(F, F.out, (const bf16*)(F.ws + WS_Z), F.out, 1, nullptr); }
#undef IN
#undef SEAM
}


extern "C" void kernel_launch(void* const* d_in, const int* in_sizes, int n_in, void* d_out, int out_size, void* d_ws, size_t ws_size, hipStream_t stream) {
    static int grid = 0;
    if (grid == 0) {
        if (n_in != 15 || in_sizes[0] != M * DM || out_size != M * DM || ws_size < WS_END) { fprintf(stderr, "kernel_launch: unexpected shapes (n_in %d, in0 %d, out %d, ws %zu < %zu)\n", n_in, n_in > 0 ? in_sizes[0] : -1, out_size, ws_size, (size_t)WS_END); grid = -1; return; }
        int dev = 0, cus = 0;
        if (hipGetDevice(&dev) != hipSuccess || hipDeviceGetAttribute(&cus, hipDeviceAttributeMultiprocessorCount, dev) != hipSuccess) { grid = -1; return; }
        if (hipFuncSetAttribute((const void*)fwd_kernel, hipFuncAttributeMaxDynamicSharedMemorySize, LDS_BYTES) != hipSuccess) { fprintf(stderr, "kernel_launch: hipFuncSetAttribute failed\n"); grid = -1; return; }
        grid = cus;
    }
    if (grid < 0) return;
    (void)hipMemsetAsync((char*)d_ws + WS_CTL, 0, CTL_ZERO_BYTES, stream);
    Args a{};
    for (int i = 0; i < 15; ++i) a.in[i] = (const float*)d_in[i];
    a.out = (float*)d_out; a.ws = (unsigned char*)d_ws;
#if MK_PER_PHASE
    for (int p = 0; p < NPHASES; ++p) { a.ph_lo = p; a.ph_hi = p + 1; hipLaunchKernelGGL(fwd_kernel, dim3(grid), dim3(NTHREADS), LDS_BYTES, stream, a); }
#else
    a.ph_lo = 0; a.ph_hi = NPHASES; hipLaunchKernelGGL(fwd_kernel, dim3(grid), dim3(NTHREADS), LDS_BYTES, stream, a);
#endif
}
```

```cpp
#include <hip/hip_runtime.h>
#include <cstdio>
#include <cstdint>

#ifndef MK_PER_PHASE
#define MK_PER_PHASE 0
#endif
#ifndef MLA_TUNED
#define MLA_TUNED 1
#endif
#ifndef DOUBLE_MASK
#define DOUBLE_MASK 0
#endif
#ifndef LAMBDA_A
#define LAMBDA_A 1.0f
#endif
#ifndef LAMBDA_B
#define LAMBDA_B 1.0f
#endif
#ifndef SELFCHECK
#define SELFCHECK 0
#define REPORT_STAGE 0
#endif

#define GAS __attribute__((address_space(1)))
#define LAS __attribute__((address_space(3)))

namespace pg8 {
typedef unsigned short bf16_t;
typedef short bf16x8 __attribute__((ext_vector_type(8)));
typedef float f32x4 __attribute__((ext_vector_type(4)));
typedef unsigned u32x4 __attribute__((ext_vector_type(4)));
constexpr int BM = 256, BK = 64, HALF = 128, HTB = HALF * BK * 2, STAGE_BYTES = 8 * HTB, NXCD = 8, WGM = 8;

__host__ __device__ __forceinline__ int lds_byte(int r, int c) { const int st = (r >> 4) * 2 + (c >> 5), rr = r & 15, cc = c & 31, ob = rr * 64 + cc * 2; return st * 1024 + (ob ^ (((ob >> 9) & 1) << 5)); }
__host__ __device__ __forceinline__ void stage_rc(int b, int& R, int& C) { const int st = b / 1024, sb = b % 1024, swz = sb ^ (((sb >> 9) & 1) << 5); R = (st >> 1) * 16 + swz / 64; C = (st & 1) * 32 + (swz % 64) / 2; }
__host__ __device__ __forceinline__ int perm32(int rho) { const int n = rho >> 4, i = rho & 15; return 8 * (i >> 2) + 4 * n + (i & 3); }

struct Unit { int pm, pn; };
struct Gemm { const bf16_t* A; const bf16_t* Bt; int M, N, K, lda; };

struct StaticOrder {
    int nM, nN, nwg, G, c;
    __host__ __device__ void init(int M, int N, int G_, int c_) { nM = M / BM; nN = N / BM; nwg = nM * nN; G = G_; c = c_; }
    __host__ __device__ bool next(int i, Unit& u) const {
        const long L = (long)i * G + c; if (L >= nwg) return false;
        int wgid = (int)L; { const int q = nwg / NXCD, r = nwg % NXCD, xcd = wgid % NXCD, off = wgid / NXCD; wgid = (xcd < r ? xcd * (q + 1) : r * (q + 1) + (xcd - r) * q) + off; }
        const int nig = WGM * nN, gid = wgid / nig, fm = gid * WGM, gsz = (nM - fm) < WGM ? (nM - fm) : WGM;
        u.pm = fm + ((wgid % nig) % gsz); u.pn = (wgid % nig) / gsz; return true;
    }
};

__device__ __forceinline__ unsigned cvt_pk_bf16(float lo, float hi) { unsigned r; asm volatile("v_cvt_pk_bf16_f32 %0, %1, %2" : "=v"(r) : "v"(lo), "v"(hi)); return r; }

struct EpiBf16 {
    static constexpr bool PERM = true;
    bf16_t* O; int ldc;
    __device__ __forceinline__ void operator()(const f32x4 (&acc)[2][2][4][2], const Unit& u, int wr, int wc, int fr, int fq) const {
        const int row0 = u.pm * BM + wr * 64 + fr; const int col0 = u.pn * BM + wc * 32 + 8 * fq;
#pragma unroll
        for (int ai = 0; ai < 2; ++ai)
#pragma unroll
            for (int m = 0; m < 4; ++m) { bf16_t* rowp = O + (size_t)(row0 + ai * HALF + m * 16) * ldc + col0;
#pragma unroll
                for (int bj = 0; bj < 2; ++bj) { const f32x4 v0 = acc[ai][bj][m][0], v1 = acc[ai][bj][m][1];
                    u32x4 w; w.x = cvt_pk_bf16(v0[0], v0[1]); w.y = cvt_pk_bf16(v0[2], v0[3]); w.z = cvt_pk_bf16(v1[0], v1[1]); w.w = cvt_pk_bf16(v1[2], v1[3]);
                    *(u32x4*)(rowp + bj * HALF) = w; } }
    }
};

template <class Epi, class Sched, bool ALIGN_EPI = true>
__device__ __forceinline__ void gemm_phase(LAS unsigned char* lds, const Gemm g, const Sched& S, const Epi& E) {
    const int tid = threadIdx.x, wid = __builtin_amdgcn_readfirstlane(tid >> 6), lane = tid & 63, wr = wid >> 2, wc = wid & 3, fr = lane & 15, fq = lane >> 4;
    const int K = g.K, nt = K / BK;
    unsigned voffA[2], voffB[2];
#pragma unroll
    for (int i = 0; i < 2; ++i) { int R, C; stage_rc(tid * 16 + i * 8192, R, C); const int Rb = Epi::PERM ? ((R & ~31) + perm32(R & 31)) : R;
        voffA[i] = (unsigned)(R * g.lda + C) * 2u; voffB[i] = (unsigned)(Rb * K + C) * 2u; }
    const size_t kstep = (size_t)(BK * 2);
    const size_t hstepA = (size_t)HALF * g.lda * 2, hstepB = (size_t)HALF * K * 2;
    const size_t tstepA = 2 * hstepA, tstepB = 2 * hstepB;
    const unsigned ldsw = (unsigned)wid * 1024u;
    const int aoff = lds_byte(wr * 64 + fr, fq * 8), boff = lds_byte(wc * 32 + fr, fq * 8);
#define PG8_SA(b, h) (((b) * 2 + (h)) * HTB)
#define PG8_SB(b, h) ((4 + (b) * 2 + (h)) * HTB)
#define PG8_STAGE(bufoff, gbase, voff) do { _Pragma("unroll") for (int _i = 0; _i < 2; ++_i) \
        __builtin_amdgcn_global_load_lds((const unsigned*)((const char*)(gbase) + (voff)[_i]), (LAS unsigned*)(lds + (bufoff) + ldsw + _i * 8192), 16, 0, 0); } while (0)
#define PG8_LDA(dst, b, h) do { _Pragma("unroll") for (int m = 0; m < 4; ++m) _Pragma("unroll") for (int k = 0; k < 2; ++k) dst[m][k] = *(const LAS bf16x8*)(lds + PG8_SA(b, h) + aoff + m * 2048 + k * 1024); } while (0)
#define PG8_LDB(dst, b, h) do { _Pragma("unroll") for (int n = 0; n < 2; ++n) _Pragma("unroll") for (int k = 0; k < 2; ++k) dst[n][k] = *(const LAS bf16x8*)(lds + PG8_SB(b, h) + boff + n * 2048 + k * 1024); } while (0)
#define PG8_MMA(ai, bj, At, Bt) do { __builtin_amdgcn_s_setprio(1); _Pragma("unroll") for (int m = 0; m < 4; ++m) _Pragma("unroll") for (int n = 0; n < 2; ++n) _Pragma("unroll") for (int k = 0; k < 2; ++k) \
        acc[ai][bj][m][n] = __builtin_amdgcn_mfma_f32_16x16x32_bf16(Bt[n][k], At[m][k], acc[ai][bj][m][n], 0, 0, 0); __builtin_amdgcn_s_setprio(0); } while (0)
#define PG8_WAIT_V(n) asm volatile("s_waitcnt vmcnt(" #n ")" ::: "memory")
#define PG8_WAIT_L(n) asm volatile("s_waitcnt lgkmcnt(" #n ")" ::: "memory")
#define PG8_BAR __builtin_amdgcn_s_barrier()
#define PG8_SCHED __builtin_amdgcn_sched_barrier(0)
    Unit cur, nxt; int ui = 0;
    if (!S.next(0, cur)) return;
    f32x4 acc[2][2][4][2];
#pragma unroll
    for (int a = 0; a < 2; ++a)
#pragma unroll
        for (int b = 0; b < 2; ++b)
#pragma unroll
            for (int m = 0; m < 4; ++m)
#pragma unroll
                for (int n = 0; n < 2; ++n) acc[a][b][m][n] = (f32x4){0.f, 0.f, 0.f, 0.f};
    bf16x8 At[4][2], B0[2][2], B1[2][2];
    const char* cA = (const char*)g.A + (size_t)cur.pm * tstepA; const char* cB = (const char*)g.Bt + (size_t)cur.pn * tstepB;
    PG8_STAGE(PG8_SB(0, 0), cB, voffB); PG8_STAGE(PG8_SB(0, 1), cB + hstepB, voffB); PG8_STAGE(PG8_SA(0, 0), cA, voffA); PG8_STAGE(PG8_SA(0, 1), cA + hstepA, voffA);
    if (wr == 1) PG8_BAR;
    PG8_WAIT_V(2); PG8_BAR;
    PG8_STAGE(PG8_SB(1, 0), cB + kstep, voffB); PG8_STAGE(PG8_SA(1, 0), cA + kstep, voffA); PG8_STAGE(PG8_SB(1, 1), cB + hstepB + kstep, voffB);
    PG8_WAIT_V(6); PG8_BAR;
    for (;;) {
        const bool has_next = S.next(ui + 1, nxt);
        const char* nA = has_next ? (const char*)g.A + (size_t)nxt.pm * tstepA : cA; const char* nB = has_next ? (const char*)g.Bt + (size_t)nxt.pn * tstepB : cB;
        for (int t = 0; t < nt; t += 2) {
            const bool last = (t == nt - 2);
            const char* a1 = cA + (size_t)(t + 1) * kstep;
            const char* a2 = last ? nA : cA + (size_t)(t + 2) * kstep; const char* b2 = last ? nB : cB + (size_t)(t + 2) * kstep;
            const char* a3 = a2 + kstep; const char* b3 = b2 + kstep;
            PG8_LDB(B0, 0, 0); PG8_LDB(B1, 0, 1); PG8_SCHED; PG8_LDA(At, 0, 0); PG8_STAGE(PG8_SA(1, 1), a1 + hstepA, voffA);
            PG8_WAIT_V(8); PG8_WAIT_L(0); PG8_BAR; PG8_MMA(0, 0, At, B0); PG8_MMA(0, 1, At, B1); PG8_BAR; PG8_SCHED;
            PG8_LDA(At, 0, 1); PG8_STAGE(PG8_SB(0, 0), b2, voffB); PG8_STAGE(PG8_SB(0, 1), b2 + hstepB, voffB); PG8_STAGE(PG8_SA(0, 0), a2, voffA);
            PG8_WAIT_V(8); PG8_WAIT_L(0); PG8_BAR; PG8_MMA(1, 0, At, B0); PG8_MMA(1, 1, At, B1); PG8_BAR; PG8_SCHED;
            PG8_LDB(B0, 1, 0); PG8_LDB(B1, 1, 1); PG8_SCHED; PG8_LDA(At, 1, 0); PG8_STAGE(PG8_SA(0, 1), a2 + hstepA, voffA);
            PG8_WAIT_V(8); PG8_WAIT_L(0); PG8_BAR; PG8_MMA(0, 0, At, B0); PG8_MMA(0, 1, At, B1); PG8_BAR; PG8_SCHED;
            PG8_LDA(At, 1, 1); PG8_STAGE(PG8_SB(1, 0), b3, voffB); PG8_STAGE(PG8_SB(1, 1), b3 + hstepB, voffB); PG8_STAGE(PG8_SA(1, 0), a3, voffA);
            PG8_WAIT_V(8); PG8_WAIT_L(0); PG8_BAR; PG8_MMA(1, 0, At, B0); PG8_MMA(1, 1, At, B1); PG8_BAR; PG8_SCHED;
        }
        if constexpr (ALIGN_EPI) { if (wr == 0) PG8_BAR; }
        E(acc, cur, wr, wc, fr, fq);
        if (!has_next) break;
#pragma unroll
        for (int a = 0; a < 2; ++a)
#pragma unroll
            for (int b = 0; b < 2; ++b)
#pragma unroll
                for (int m = 0; m < 4; ++m)
#pragma unroll
                    for (int n = 0; n < 2; ++n) acc[a][b][m][n] = (f32x4){0.f, 0.f, 0.f, 0.f};
        cur = nxt; cA = nA; cB = nB; ++ui;
        if constexpr (ALIGN_EPI) { if (wr == 1) PG8_BAR; }
    }
    PG8_WAIT_V(0);
    if constexpr (!ALIGN_EPI) { if (wr == 0) PG8_BAR; }
    PG8_BAR;
#undef PG8_SA
#undef PG8_SB
#undef PG8_STAGE
#undef PG8_LDA
#undef PG8_LDB
#undef PG8_MMA
#undef PG8_WAIT_V
#undef PG8_WAIT_L
#undef PG8_BAR
#undef PG8_SCHED
}
}

constexpr int NWAVES = 8, NTHREADS = NWAVES * 64;
constexpr int BATCH = 8, SEQ = 4096, DM = 1024, M = BATCH * SEQ;
constexpr int WA = 1152, NA = 4 * WA, HA = 18;
constexpr int NBIN = 1440, NBP = 1536, QL = 256, KVL = 128, RD = 32, HB = 16;
constexpr int QW = HB * 96, KVW = HB * 128, C1N_LD = 512, GATE1_OFF = QL + KVL + RD;
constexpr float LN_EPS = 1e-5f, RMS_EPS = 1e-6f, ALPHA = 1.41421356237309515f, LOG2E = 1.4426950408889634f, LN2 = 0.69314718055994531f;
constexpr float QSCALE_A = 0.125f * LOG2E;
constexpr float QSCALE_B = 0.10206207261596577f * LOG2E;

constexpr size_t MiB = 1u << 20;
constexpr size_t WS_CTL = 0, CTL_ZERO_BYTES = 1 * MiB;
constexpr size_t WS_MOD = 1 * MiB;
constexpr size_t WS_ROPE = 1 * MiB + 512 * 1024;
constexpr size_t WS_WIN0 = 2 * MiB, WS_WOUT0 = 11 * MiB + 256 * 1024, WS_WIN1 = 14 * MiB, WS_WUQ = 17 * MiB, WS_WUKV = 18 * MiB, WS_WOUT1 = 19 * MiB;
constexpr size_t WS_U = 24 * MiB;
constexpr size_t WS_BIG = 88 * MiB;
constexpr size_t WS_QKVG = WS_BIG;
constexpr size_t WS_O0 = WS_BIG + 288 * MiB;
constexpr size_t WS_LSE = WS_O0 + 72 * MiB;
constexpr size_t WS_Z = WS_BIG;
constexpr size_t WS_C1 = WS_BIG;
constexpr size_t WS_Q1 = WS_BIG + 96 * MiB;
constexpr size_t WS_KV1 = WS_BIG + 192 * MiB;
constexpr size_t WS_C1N = WS_BIG + 320 * MiB;
constexpr size_t WS_END = WS_LSE + 3 * MiB;
static_assert(WS_C1N + (size_t)M * C1N_LD * 2 <= WS_END && WS_WOUT0 + (size_t)DM * WA * 2 <= WS_WIN1 && WS_WIN0 + (size_t)NA * DM * 2 <= WS_WOUT0, "ws map");
constexpr int CW_TMO = 0, CW_CODE = 1, CW_ERR = 64, CW_BAR = 4096;

constexpr int RING_BYTES = 143360;
constexpr int LDSCTL_OFF = RING_BYTES, MISC_OFF = LDSCTL_OFF + 320;
constexpr int LDS_BYTES = 147456;

typedef unsigned short bf16;
typedef unsigned v4u __attribute__((ext_vector_type(4)));
typedef unsigned v2u __attribute__((ext_vector_type(2)));
typedef float f32x4 __attribute__((ext_vector_type(4)));
typedef float f32x2 __attribute__((ext_vector_type(2)));
typedef float f32x16 __attribute__((ext_vector_type(16)));
typedef short bf16x8 __attribute__((ext_vector_type(8)));
typedef short s16x4 __attribute__((ext_vector_type(4)));
typedef GAS unsigned gu32;
#define RLX_AGENT __ATOMIC_RELAXED, __HIP_MEMORY_SCOPE_AGENT
#define LDS_WAIT() asm volatile("s_waitcnt lgkmcnt(0)" ::: "memory")
#define VM_WAIT() asm volatile("s_waitcnt vmcnt(0)" ::: "memory")
__device__ __forceinline__ unsigned f2bf(float f) { unsigned u = __builtin_bit_cast(unsigned, f); return (u + 0x7fffu + ((u >> 16) & 1u)) >> 16; }
__device__ __forceinline__ unsigned pk2(float lo, float hi) { return f2bf(lo) | (f2bf(hi) << 16); }
__device__ __forceinline__ float bflo(unsigned w) { return __uint_as_float(w << 16); }
__device__ __forceinline__ float bfhi(unsigned w) { return __uint_as_float(w & 0xffff0000u); }
__device__ __forceinline__ float bf2f(bf16 h) { return __uint_as_float(((unsigned)h) << 16); }
__device__ __forceinline__ float silu_f(float v) { return v / (1.0f + __expf(-v)); }
__device__ __forceinline__ int crow(int r, int hi) { return (r & 3) + 8 * (r >> 2) + 4 * hi; }

#define XB_TMO      128
#define XB_XCNT(j)  (256  + 64 * (j))
#define XB_XSUB(j)  (1280 + 64 * (j))
#define XB_XGEN(j)  (2304 + 64 * (j))
#define XB_TOP      3328
#define XB_TOPGEN   3392
#define XCD_BAR_WORDS 3456
#define XB_SPIN_CAP (1u << 18)
__device__ __forceinline__ unsigned xb_ld(unsigned* p)              { return __hip_atomic_load(p, __ATOMIC_RELAXED, __HIP_MEMORY_SCOPE_AGENT); }
__device__ __forceinline__ unsigned xb_add(unsigned* p, unsigned v) { return __hip_atomic_fetch_add(p, v, __ATOMIC_RELAXED, __HIP_MEMORY_SCOPE_AGENT); }
__device__ __forceinline__ unsigned xb_xcc_id() { return (unsigned)__builtin_amdgcn_s_getreg((3 << 11) | 20) & 0xFu; }
#define XB_SPIN(cond, bar) do { unsigned _sp = 0; while (cond) { __builtin_amdgcn_s_sleep(1); \
    if ((++_sp & 255u) == 0u) { if (xb_ld(&(bar)[XB_TMO])) break; if (_sp > XB_SPIN_CAP) { atomicAdd(&(bar)[XB_TMO], 1u); break; } } } } while (0)
struct XcdBarrier { unsigned* bar; unsigned x; volatile LAS unsigned* st; };
__device__ __forceinline__ XcdBarrier xcd_barrier_post(unsigned* bar, volatile LAS unsigned* st) {
    XcdBarrier b; b.bar = bar; b.x = xb_xcc_id(); b.st = st;
    if (threadIdx.x == 0) (void)xb_add(&bar[XB_XCNT(b.x)], 1u);
    return b;
}
__device__ __forceinline__ void xcd_barrier_complete(unsigned* bar, unsigned x, unsigned& nloc, unsigned& nx) {
    const unsigned G = gridDim.x * gridDim.y * gridDim.z;
    unsigned sum, cnt, mine, sp = 0u;
    for (;;) {
        sum = 0u; cnt = 0u; mine = 0u;
#pragma unroll
        for (unsigned j = 0; j < 16; ++j) { const unsigned c = xb_ld(&bar[XB_XCNT(j)]); sum += c; cnt += (c > 0u) ? 1u : 0u; mine = (j == x) ? c : mine; }
        if (sum == G) break;
        __builtin_amdgcn_s_sleep(1);
        if ((++sp & 255u) == 0u) { if (xb_ld(&bar[XB_TMO])) break; if (sp > XB_SPIN_CAP) { atomicAdd(&bar[XB_TMO], 1u); break; } }
    }
    nloc = mine > 0u ? mine : 1u; nx = cnt > 0u ? cnt : 1u;
}
__device__ __forceinline__ void xcd_barrier(const XcdBarrier& b) {
    asm volatile("s_waitcnt vmcnt(0)" ::: "memory");
    __syncthreads();
    if (threadIdx.x == 0) {
        unsigned* bar = b.bar;
        __builtin_amdgcn_s_waitcnt(0);
        unsigned nloc = b.st[0], nx = b.st[1];
        if (nloc == 0u) { xcd_barrier_complete(bar, b.x, nloc, nx); b.st[0] = nloc; b.st[1] = nx; }
        const unsigned old = xb_add(&bar[XB_XSUB(b.x)], 1u);
        const unsigned gen = old / nloc;
        if (old + 1u == (gen + 1u) * nloc) {
            __builtin_amdgcn_fence(__ATOMIC_RELEASE, "agent");
            asm volatile("s_waitcnt vmcnt(0)" ::: "memory");
            const unsigned og = xb_add(&bar[XB_TOP], 1u);
            const unsigned tg = og / nx;
            if (og + 1u == (tg + 1u) * nx) xb_add(&bar[XB_TOPGEN], 1u);
            else XB_SPIN(xb_ld(&bar[XB_TOPGEN]) == tg, bar);
            __builtin_amdgcn_fence(__ATOMIC_ACQUIRE, "agent");
            xb_add(&bar[XB_XGEN(b.x)], 1u);
            asm volatile("s_waitcnt vmcnt(0)" ::: "memory");
        } else {
            XB_SPIN(xb_ld(&bar[XB_XGEN(b.x)]) == gen, bar);
            __builtin_amdgcn_fence(__ATOMIC_ACQUIRE, "agent");
            asm volatile("s_waitcnt vmcnt(0)" ::: "memory");
        }
    }
    __syncthreads();
}

struct Frame {
    LAS unsigned char* lds;
    int tid, lane, wave, vcu, G;
    const float *x, *c, *rel_bias, *ada_w, *ada_b, *ln_g, *ln_b, *a_w_in, *a_w_out, *b_w_in, *b_q_norm, *b_w_uq, *b_kv_norm, *b_w_ukv, *b_w_out;
    float* out; unsigned char* ws;
};
__device__ __forceinline__ float wave_sum(float v) {
#pragma unroll
    for (int o = 1; o < 64; o <<= 1) v += __shfl_xor(v, o);
    return v;
}

__device__ __forceinline__ void p0_transpose_item(const float* W, int K, int N, bf16* WT, int ldt, LAS float* scr, int item, int lane, float scale_lo, int nsplit, const float* rowscale) {
    const int nblk = N / 32, kb = item / nblk, nb = item % nblk, k0 = 64 * kb, n0 = 32 * nb;
    const float sc = (n0 < nsplit) ? scale_lo : 1.0f;
#pragma unroll 8
    for (int i = 0; i < 32; ++i) { const int kk = 2 * i + (lane >> 5); const float rs = rowscale ? rowscale[k0 + kk] : 1.0f; scr[kk * 33 + (lane & 31)] = W[(size_t)(k0 + kk) * N + n0 + (lane & 31)] * (sc * rs); }
    LDS_WAIT(); asm volatile("" ::: "memory");
    const int c = lane & 7;
#pragma unroll
    for (int j = 0; j < 4; ++j) { const int n = (lane >> 3) + 8 * j; const LAS float* s = scr + (8 * c) * 33 + n;
        v4u o; o.x = pk2(s[0 * 33], s[1 * 33]); o.y = pk2(s[2 * 33], s[3 * 33]); o.z = pk2(s[4 * 33], s[5 * 33]); o.w = pk2(s[6 * 33], s[7 * 33]);
        *(GAS v4u*)(WT + (size_t)(n0 + n) * ldt + k0 + 8 * c) = o; }
    LDS_WAIT(); asm volatile("" ::: "memory");
}
__device__ __forceinline__ void p0_prologue(Frame& F) {
    if (F.vcu < 96) {
        LAS float* sc = (LAS float*)F.lds;
        LAS float* red = (LAS float*)(F.lds + 32768);
        for (int idx = F.tid; idx < 8 * 1024; idx += NTHREADS) sc[idx] = silu_f(F.c[idx]);
        __syncthreads();
        const int i = F.vcu / 48, nb = F.vcu % 48, n = nb * 64 + F.lane, k0 = F.wave * 128;
        const float* W = F.ada_w + (size_t)i * DM * 3 * DM + n;
        float acc[8];
#pragma unroll
        for (int b = 0; b < 8; ++b) acc[b] = 0.f;
#pragma unroll 8
        for (int kk = 0; kk < 128; ++kk) { const float w = W[(size_t)(k0 + kk) * (3 * DM)];
#pragma unroll
            for (int b = 0; b < 8; ++b) acc[b] += sc[b * 1024 + k0 + kk] * w; }
#pragma unroll
        for (int b = 0; b < 8; ++b) red[(F.wave * 8 + b) * 64 + F.lane] = acc[b];
        __syncthreads();
        { const int b = F.tid >> 6; float s = 0.f;
#pragma unroll
          for (int w = 0; w < 8; ++w) s += red[(w * 8 + b) * 64 + F.lane];
          ((float*)(F.ws + WS_MOD))[(size_t)(i * 8 + b) * (3 * DM) + n] = s + F.ada_b[i * 3 * DM + n]; }
        __syncthreads();
    }
    LAS float* scr = (LAS float*)(F.lds + F.wave * 16384);
    const int gw = F.vcu * NWAVES + F.wave, NGW = F.G * NWAVES;
    constexpr int I0 = (DM / 64) * (NA / 32), I1 = (WA / 64) * (DM / 32), I2 = (DM / 64) * (NBIN / 32), I3 = (QL / 64) * (QW / 32), I4 = (KVL / 64) * (KVW / 32), I5 = (DM / 64) * (DM / 32);
    constexpr int NITEMS = I0 + I1 + I2 + I3 + I4 + I5;
    for (int it = gw; it < NITEMS; it += NGW) {
        int r = it;
        if (r < I0) { p0_transpose_item(F.a_w_in, DM, NA, (bf16*)(F.ws + WS_WIN0), DM, scr, r, F.lane, QSCALE_A, WA, nullptr); continue; } r -= I0;
        if (r < I1) { p0_transpose_item(F.a_w_out, WA, DM, (bf16*)(F.ws + WS_WOUT0), WA, scr, r, F.lane, 1.f, 0, nullptr); continue; } r -= I1;
        if (r < I2) { p0_transpose_item(F.b_w_in, DM, NBIN, (bf16*)(F.ws + WS_WIN1), DM, scr, r, F.lane, 1.f, 0, nullptr); continue; } r -= I2;
        if (r < I3) { p0_transpose_item(F.b_w_uq, QL, QW, (bf16*)(F.ws + WS_WUQ), QL, scr, r, F.lane, QSCALE_B, QW, F.b_q_norm); continue; } r -= I3;
        if (r < I4) { p0_transpose_item(F.b_w_ukv, KVL, KVW, (bf16*)(F.ws + WS_WUKV), 256, scr, r, F.lane, 1.f, 0, F.b_kv_norm); continue; } r -= I4;
        p0_transpose_item(F.b_w_out, DM, DM, (bf16*)(F.ws + WS_WOUT1), DM, scr, r, F.lane, 1.f, 0, nullptr);
    }
    { const int gt = F.vcu * NTHREADS + F.tid, NGT = F.G * NTHREADS; const v4u z = {0u, 0u, 0u, 0u};
      for (int i = gt; i < (NBP - NBIN) * DM / 8; i += NGT) *(GAS v4u*)((bf16*)(F.ws + WS_WIN1) + (size_t)NBIN * DM + (size_t)i * 8) = z;
      for (int i = gt; i < KVW * 16; i += NGT) { const int n = i >> 4, cch = i & 15; *(GAS v4u*)((bf16*)(F.ws + WS_WUKV) + (size_t)n * 256 + 128 + cch * 8) = z; }
      for (int i = gt; i < SEQ * 16; i += NGT) { const int pos = i >> 4, fi = i & 15; const float inv = powf(10000.0f, -(float)(2 * fi) / 32.0f); const float ang = (float)pos * inv;
          ((f32x2*)(F.ws + WS_ROPE))[i] = (f32x2){cosf(ang), sinf(ang)}; } }
}

__device__ __forceinline__ void p0b_modulate(Frame& F) {
    const int gw = F.vcu * NWAVES + F.wave, NGW = F.G * NWAVES, RPW = (M + NGW - 1) / NGW;
    const float* mod = (const float*)(F.ws + WS_MOD);
    for (int m0 = gw * RPW; m0 < min(M, (gw + 1) * RPW); ) {
        const int b = m0 / SEQ, mend = min(min(M, (gw + 1) * RPW), (b + 1) * SEQ);
        const f32x4* sh = (const f32x4*)(mod + (size_t)b * 3 * DM) + F.lane; const f32x4* scp = (const f32x4*)(mod + (size_t)b * 3 * DM + DM) + F.lane;
        f32x4 shv[4], scv[4];
#pragma unroll
        for (int j = 0; j < 4; ++j) { shv[j] = sh[64 * j]; scv[j] = scp[64 * j] + 1.0f; }
        for (int m = m0; m < mend; ++m) {
            const GAS f32x4* xr = (const GAS f32x4*)(F.x + (size_t)m * DM) + F.lane;
            GAS v2u* o8 = (GAS v2u*)((bf16*)(F.ws + WS_U) + (size_t)m * DM) + F.lane;
            f32x4 v[4];
#pragma unroll
            for (int j = 0; j < 4; ++j) v[j] = xr[64 * j];
#pragma unroll
            for (int j = 0; j < 4; ++j) { const f32x4 u = v[j] * scv[j] + shv[j]; o8[64 * j] = (v2u){pk2(u.x, u.y), pk2(u.z, u.w)}; }
        }
        m0 = mend;
    }
}

namespace dil {
constexpr int KROWS = 384, KPLANE = KROWS * 16 + 16, VPLANE = KROWS * 64 + 64;
constexpr int L_K = 0, L_V = 8 * KPLANE, L_BIAS = L_V + 2 * VPLANE, L_WS = L_BIAS + 768, L_OST = L_WS + NWAVES * 256, L_END = L_OST + NWAVES * 4096;
static_assert(L_END <= RING_BYTES, "dilated attention LDS");
constexpr int NUNITS = BATCH * HA * 16;
__device__ __forceinline__ int t5_bucket(int rel) {
    const int base = rel > 0 ? 16 : 0; const int n = rel < 0 ? -rel : rel; const float nf = (float)(n > 1 ? n : 1);
    int large = 8 + (int)(logf(nf / 8.0f) / 4.852030263919617f * 8.0f); large = large < 15 ? large : 15;
    return base + (n < 8 ? n : large);
}
__device__ __forceinline__ void unit(Frame& F, int u) {
    const int blk = u & 15, h = (u >> 4) % HA, b = u / (16 * HA), g = h / 6;
    const int d = (g == 0) ? 1 : (g == 1 ? 4 : 16), L = SEQ / d, nblk = L / 256;
    const int rcls = blk / nblk, jb = blk % nblk, jstart = 256 * jb - 64;
    const bf16* QKVG = (const bf16*)(F.ws + WS_QKVG);
    LAS unsigned char* lds = F.lds; const int tid = F.tid, lane = F.lane, wid = F.wave, r32 = lane & 31, hi = lane >> 5;
    {   v4u kv[6], vv[6];
#pragma unroll
        for (int i = 0; i < 6; ++i) { const int p = tid + i * NTHREADS, row = p >> 3, c = p & 7, j = jstart + row; const bool ok = (j >= 0 && j < L);
            const size_t grow = (size_t)b * SEQ + rcls + (size_t)d * (ok ? j : 0);
            const GAS v4u* src = (const GAS v4u*)(QKVG + grow * NA + WA + h * 64 + c * 8);
            kv[i] = ok ? src[0] : (v4u){0u, 0u, 0u, 0u}; vv[i] = ok ? src[WA / 8] : (v4u){0u, 0u, 0u, 0u}; }
#pragma unroll
        for (int i = 0; i < 6; ++i) { const int p = tid + i * NTHREADS, row = p >> 3, c = p & 7;
            *(LAS v4u*)(lds + L_K + c * KPLANE + row * 16) = kv[i];
            *(LAS v4u*)(lds + L_V + (c >> 2) * VPLANE + row * 64 + (c & 3) * 16) = vv[i]; }
        if (tid < 192) { const int off = tid - 95; const int ao = off < 0 ? -off : off;
            ((LAS float*)(lds + L_BIAS))[tid] = (ao <= 64) ? F.rel_bias[t5_bucket(off * d) * HA + h] * LOG2E : -1e30f; }
    }
    const int jq = 256 * jb + 32 * wid + r32; const size_t growq = (size_t)b * SEQ + rcls + (size_t)d * jq;
    bf16x8 qr[4];
#pragma unroll
    for (int d0 = 0; d0 < 4; ++d0) qr[d0] = *(const GAS bf16x8*)(QKVG + growq * NA + h * 64 + d0 * 16 + hi * 8);
    __syncthreads();
    f32x16 s[5];
#pragma unroll
    for (int i = 0; i < 5; ++i) {
        s[i] = (f32x16){0};
#pragma unroll
        for (int d0 = 0; d0 < 4; ++d0) { const bf16x8 a = *(const LAS bf16x8*)(lds + L_K + (2 * d0 + hi) * KPLANE + (32 * wid + 32 * i + r32) * 16);
            s[i] = __builtin_amdgcn_mfma_f32_32x32x16_bf16(a, qr[d0], s[i], 0, 0, 0); }
    }
    const LAS float* biasl = (const LAS float*)(lds + L_BIAS);
    const int jk0 = jstart + 32 * wid + 4 * hi; float mx = -3.0e38f;
#pragma unroll
    for (int i = 0; i < 5; ++i)
#pragma unroll
        for (int r = 0; r < 16; ++r) { const int kk = 32 * i + (r & 3) + 8 * (r >> 2); const int jk = jk0 + kk; const int idx = kk + 4 * hi - r32 + 31;
            float v = s[i][r] + biasl[idx]; v = (jk >= 0 && jk < L) ? v : -1e30f; s[i][r] = v; mx = fmaxf(mx, v); }
    mx = fmaxf(mx, __shfl_xor(mx, 32));
    float l = 0.f;
#pragma unroll
    for (int i = 0; i < 5; ++i)
#pragma unroll
        for (int r = 0; r < 16; ++r) { const float p = __builtin_amdgcn_exp2f(s[i][r] - mx); s[i][r] = p; l += p; }
    l += __shfl_xor(l, 32);
    f32x16 o[2]; o[0] = (f32x16){0}; o[1] = (f32x16){0};
    const int vlane = ((lane >> 4) & 1) * 32 + (lane & 3) * 8 + (4 * hi + ((lane & 15) >> 2)) * 64;
#pragma unroll
    for (int i = 0; i < 5; ++i)
#pragma unroll
        for (int ks = 0; ks < 2; ++ks) {
            v4u pw; pw.x = pg8::cvt_pk_bf16(s[i][8 * ks + 0], s[i][8 * ks + 1]); pw.y = pg8::cvt_pk_bf16(s[i][8 * ks + 2], s[i][8 * ks + 3]);
            pw.z = pg8::cvt_pk_bf16(s[i][8 * ks + 4], s[i][8 * ks + 5]); pw.w = pg8::cvt_pk_bf16(s[i][8 * ks + 6], s[i][8 * ks + 7]);
            const bf16x8 pa = __builtin_bit_cast(bf16x8, pw);
#pragma unroll
            for (int d0 = 0; d0 < 2; ++d0) { LAS unsigned char* vp = lds + L_V + d0 * VPLANE + (32 * wid + 32 * i + 16 * ks) * 64 + vlane;
                const s16x4 lo = __builtin_bit_cast(s16x4, __builtin_amdgcn_ds_read_tr16_b64_v4i16((LAS s16x4*)vp));
                const s16x4 hh = __builtin_bit_cast(s16x4, __builtin_amdgcn_ds_read_tr16_b64_v4i16((LAS s16x4*)(vp + 512)));
                const bf16x8 vf = (bf16x8){lo[0], lo[1], lo[2], lo[3], hh[0], hh[1], hh[2], hh[3]};
                o[d0] = __builtin_amdgcn_mfma_f32_32x32x16_bf16(pa, vf, o[d0], 0, 0, 0); }
        }
    LAS float* wsf = (LAS float*)(lds + L_WS) + wid * 64;
    if (hi == 0) { wsf[r32] = 1.0f / l; ((float*)(F.ws + WS_LSE))[growq * HA + h] = (mx + __builtin_amdgcn_logf(l)) * LN2; }
    LDS_WAIT();
    LAS bf16* stg = (LAS bf16*)(lds + L_OST) + wid * 2048;
#pragma unroll
    for (int r = 0; r < 16; ++r) { const int orow = crow(r, hi); const float rl = wsf[orow];
#pragma unroll
        for (int d0 = 0; d0 < 2; ++d0) stg[orow * 64 + d0 * 32 + r32] = (bf16)f2bf(o[d0][r] * rl); }
    LDS_WAIT();
    bf16* O0 = (bf16*)(F.ws + WS_O0);
#pragma unroll
    for (int i = 0; i < 4; ++i) { const int row = i * 8 + (lane >> 3), ch = lane & 7; const v4u v = *(const LAS v4u*)(stg + row * 64 + ch * 8);
        const size_t grow = (size_t)b * SEQ + rcls + (size_t)d * (256 * jb + 32 * wid + row);
        *(GAS v4u*)(O0 + grow * WA + h * 64 + ch * 8) = v; }
    __syncthreads();
}
}

__device__ __forceinline__ void p2b_combine(Frame& F) {
    const int gt = F.vcu * NTHREADS + F.tid, NGT = F.G * NTHREADS;
    const bf16* QKVG = (const bf16*)(F.ws + WS_QKVG); bf16* O0 = (bf16*)(F.ws + WS_O0); const float* LSE = (const float*)(F.ws + WS_LSE);
    for (int cidx = gt; cidx < M * (WA / 8); cidx += NGT) {
        const int row = cidx / (WA / 8), hc = cidx % (WA / 8), head = hc >> 3, hg = head % 6, g = head / 6;
        const float l0 = LSE[(size_t)row * HA + hg], l1 = LSE[(size_t)row * HA + 6 + hg], l2 = LSE[(size_t)row * HA + 12 + hg];
        const float mxl = fmaxf(l0, fmaxf(l1, l2)); const float e0 = __expf(l0 - mxl), e1 = __expf(l1 - mxl), e2 = __expf(l2 - mxl);
        const float w = (g == 0 ? e0 : (g == 1 ? e1 : e2)) / (e0 + e1 + e2);
        const v4u ov = *(const GAS v4u*)(O0 + (size_t)row * WA + hc * 8); const v4u gv = *(const GAS v4u*)(QKVG + (size_t)row * NA + 3 * WA + hc * 8);
        v4u r;
#pragma unroll
        for (int k = 0; k < 4; ++k) { const float a = bflo(ov[k]) * w * silu_f(bflo(gv[k])), bb = bfhi(ov[k]) * w * silu_f(bfhi(gv[k])); r[k] = pk2(a, bb); }
        *(GAS v4u*)(O0 + (size_t)row * WA + hc * 8) = r;
    }
}

template <bool WITH_U>
__device__ __forceinline__ void ln_pass(Frame& F, const float* xin, const bf16* Z, float* xout, int layer, bf16* U) {
    const int gw = F.vcu * NWAVES + F.wave, NGW = F.G * NWAVES, RPW = (M + NGW - 1) / NGW;
    const float* mod = (const float*)(F.ws + WS_MOD);
    for (int m0 = gw * RPW; m0 < min(M, (gw + 1) * RPW); ) {
        const int b = m0 / SEQ, mend = min(min(M, (gw + 1) * RPW), (b + 1) * SEQ);
        f32x4 gt[4], lg[4], lb[4];
#pragma unroll
        for (int j = 0; j < 4; ++j) { gt[j] = ((const f32x4*)(mod + (size_t)(layer * 8 + b) * 3 * DM + 2 * DM))[F.lane + 64 * j];
            lg[j] = ((const f32x4*)(F.ln_g + layer * DM))[F.lane + 64 * j]; lb[j] = ((const f32x4*)(F.ln_b + layer * DM))[F.lane + 64 * j]; }
        for (int m = m0; m < mend; ++m) {
            const GAS f32x4* xr = (const GAS f32x4*)(xin + (size_t)m * DM) + F.lane; const GAS v2u* zr = (const GAS v2u*)(Z + (size_t)m * DM) + F.lane;
            f32x4 v[4]; float s = 0.f;
#pragma unroll
            for (int j = 0; j < 4; ++j) { const f32x4 xv = xr[64 * j]; const v2u zv = zr[64 * j]; const f32x4 zf = (f32x4){bflo(zv.x), bfhi(zv.x), bflo(zv.y), bfhi(zv.y)};
                v[j] = xv * ALPHA + gt[j] * zf * (layer == 0 ? LAMBDA_A : LAMBDA_B); s += (v[j].x + v[j].y) + (v[j].z + v[j].w); }
            const float mean = wave_sum(s) * (1.f / DM); float s2 = 0.f;
#pragma unroll
            for (int j = 0; j < 4; ++j) { v[j] = v[j] - mean; s2 += (v[j].x * v[j].x + v[j].y * v[j].y) + (v[j].z * v[j].z + v[j].w * v[j].w); }
            const float rstd = 1.f / sqrtf(wave_sum(s2) * (1.f / DM) + LN_EPS);
            GAS f32x4* orow = (GAS f32x4*)(xout + (size_t)m * DM) + F.lane;
#pragma unroll
            for (int j = 0; j < 4; ++j) { v[j] = v[j] * rstd * lg[j] + lb[j];
#ifdef ROUND_OUT
                if (!WITH_U) { v[j].x = bflo(f2bf(v[j].x)); v[j].y = bflo(f2bf(v[j].y)); v[j].z = bflo(f2bf(v[j].z)); v[j].w = bflo(f2bf(v[j].w)); }
#endif
                orow[64 * j] = v[j]; }
            if constexpr (WITH_U) {
                GAS v2u* u8 = (GAS v2u*)(U + (size_t)m * DM) + F.lane;
#pragma unroll
                for (int j = 0; j < 4; ++j) { const f32x4 sh = ((const f32x4*)(mod + (size_t)((layer + 1) * 8 + b) * 3 * DM))[F.lane + 64 * j];
                    const f32x4 sc = ((const f32x4*)(mod + (size_t)((layer + 1) * 8 + b) * 3 * DM + DM))[F.lane + 64 * j];
                    const f32x4 u = v[j] * (sc + 1.0f) + sh; u8[64 * j] = (v2u){pk2(u.x, u.y), pk2(u.z, u.w)}; }
            }
        }
        m0 = mend;
    }
}

__device__ __forceinline__ void p4b_norm_rope(Frame& F) {
    const int gw = F.vcu * NWAVES + F.wave, NGW = F.G * NWAVES;
    const bf16* C1 = (const bf16*)(F.ws + WS_C1); bf16* C1N = (bf16*)(F.ws + WS_C1N); const f32x2* CS = (const f32x2*)(F.ws + WS_ROPE);
    for (int m = gw; m < M; m += NGW) {
        const bf16* row = C1 + (size_t)m * NBP; bf16* orow = C1N + (size_t)m * C1N_LD; const int l = F.lane;
        const v2u q4 = *(const GAS v2u*)(row + 4 * l); const unsigned k2 = *(const GAS unsigned*)(row + QL + 2 * l);
        const float q0 = bflo(q4.x), q1 = bfhi(q4.x), q2 = bflo(q4.y), q3 = bfhi(q4.y), k0 = bflo(k2), k1 = bfhi(k2);
        const float rq = 1.0f / sqrtf(wave_sum(q0 * q0 + q1 * q1 + q2 * q2 + q3 * q3) * (1.0f / QL) + RMS_EPS);
        const float rk = 1.0f / sqrtf(wave_sum(k0 * k0 + k1 * k1) * (1.0f / KVL) + RMS_EPS);
        *(GAS v2u*)(orow + 4 * l) = (v2u){pk2(q0 * rq, q1 * rq), pk2(q2 * rq, q3 * rq)};
        *(GAS unsigned*)(orow + QL + 2 * l) = pk2(k0 * rk, k1 * rk);
        if (l < 16) { const float x1 = bf2f(row[QL + KVL + l]), x2 = bf2f(row[QL + KVL + 16 + l]); const f32x2 cs = CS[(m % SEQ) * 16 + l];
            orow[QL + KVL + l] = (bf16)f2bf(x1 * cs.x - x2 * cs.y); orow[QL + KVL + 16 + l] = (bf16)f2bf(x2 * cs.x + x1 * cs.y); }
        else if (l < 64) { *(GAS unsigned*)(orow + GATE1_OFF + 2 * (l - 16)) = 0u; }
    }
}

namespace mla {
constexpr int KVBLK = 64, NT = SEQ / KVBLK, KSLOT = 12288, VSLOT = 8192;
constexpr int L_K = 0, L_V = 3 * KSLOT, L_WS = L_V + 3 * VSLOT, L_OST = L_WS + NWAVES * 256, L_END = L_OST + NWAVES * 4096;
static_assert(L_END <= RING_BYTES, "mla LDS");
constexpr int NUNITS = BATCH * HB * (SEQ / 256);
constexpr float THR = 8.0f;
__device__ __forceinline__ void glds16(const void* gsrc, unsigned lds_dst) { unsigned keep;
    asm volatile("s_mov_b32 %0, m0\n\ts_mov_b32 m0, %2\n\ts_nop 0\n\tglobal_load_lds_dwordx4 %1, off\n\ts_mov_b32 m0, %0" : "=&s"(keep) : "v"(gsrc), "s"(lds_dst) : "memory"); }
__device__ __forceinline__ void unit(Frame& F, int b, int h, int qb) {
    LAS unsigned char* lds = F.lds; const int lane = F.lane, wid = F.wave, r32 = lane & 31, hi = lane >> 5;
    const size_t rowbase = (size_t)b * SEQ; const int q0 = qb * 256;
    const bf16* KV1 = (const bf16*)(F.ws + WS_KV1); const bf16* C1N = (const bf16*)(F.ws + WS_C1N); const bf16* Q1 = (const bf16*)(F.ws + WS_Q1); const bf16* C1 = (const bf16*)(F.ws + WS_C1);
    const bf16* ksrc = KV1 + (rowbase + lane) * KVW + h * 128 + wid * 8;
    const bf16* krsrc = C1N + (rowbase + lane) * C1N_LD + QL + KVL + (wid & 3) * 8;
    const bf16* vsrc = KV1 + (rowbase + 16 * (wid & 3) + (lane >> 2)) * KVW + h * 128 + 64 + (wid >> 2) * 32 + (lane & 3) * 8;
    const unsigned lds0 = (unsigned)(uintptr_t)lds;
    const unsigned kdst = lds0 + L_K + wid * 1024, krdst = lds0 + L_K + (8 + (wid & 3)) * 1024, vdst = lds0 + L_V + wid * 1024;
    const bool w4 = wid < 4;
#define MLA_DMA(t, sk, sv) do { glds16(ksrc + (size_t)(t) * KVBLK * KVW, (unsigned)__builtin_amdgcn_readfirstlane(kdst + (sk))); \
        if (w4) glds16(krsrc + (size_t)(t) * KVBLK * C1N_LD, (unsigned)__builtin_amdgcn_readfirstlane(krdst + (sk))); \
        glds16(vsrc + (size_t)(t) * KVBLK * KVW, (unsigned)__builtin_amdgcn_readfirstlane(vdst + (sv))); } while (0)
    MLA_DMA(0, 0, 0); MLA_DMA(1, KSLOT, VSLOT);
    const bf16* qrow = Q1 + (rowbase + q0 + wid * 32 + r32) * QW + h * 96;
    bf16x8 qr[6];
#pragma unroll
    for (int d0 = 0; d0 < 6; ++d0) qr[d0] = *(const GAS bf16x8*)(qrow + d0 * 16 + hi * 8);
    { const f32x4* cs = (const f32x4*)((const f32x2*)(F.ws + WS_ROPE) + (size_t)(q0 + wid * 32 + r32) * 16 + 8 * hi);
      v4u a = __builtin_bit_cast(v4u, qr[4]), c2 = __builtin_bit_cast(v4u, qr[5]);
#pragma unroll
      for (int k = 0; k < 4; ++k) { const f32x4 cc = cs[k];
          const float x1a = bflo(a[k]), x1b = bfhi(a[k]), x2a = bflo(c2[k]), x2b = bfhi(c2[k]);
          a[k] = pk2(x1a * cc.x - x2a * cc.y, x1b * cc.z - x2b * cc.w); c2[k] = pk2(x2a * cc.x + x1a * cc.y, x2b * cc.z + x1b * cc.w); }
      qr[4] = __builtin_bit_cast(bf16x8, a); qr[5] = __builtin_bit_cast(bf16x8, c2); }
    float mref = -1e30f, l = 0.f; f32x16 o[2]; o[0] = (f32x16){0}; o[1] = (f32x16){0};
    LAS float* wsf = (LAS float*)(lds + L_WS) + wid * 64;
    const int vlane = ((lane >> 4) & 1) * 32 + (lane & 3) * 8 + (4 * hi + ((lane & 15) >> 2)) * 64;
    int sk = 0, sv = 0, sk2 = 2 * KSLOT, sv2 = 2 * VSLOT;
    for (int t = 0; t < NT; ++t) {
        if (t + 1 < NT) { if (w4) asm volatile("s_waitcnt vmcnt(3) lgkmcnt(0)\n\ts_barrier" ::: "memory"); else asm volatile("s_waitcnt vmcnt(2) lgkmcnt(0)\n\ts_barrier" ::: "memory"); }
        else asm volatile("s_waitcnt vmcnt(0) lgkmcnt(0)\n\ts_barrier" ::: "memory");
        if (t + 2 < NT) MLA_DMA(t + 2, sk2, sv2);
        f32x16 p0 = (f32x16){0}, p1 = (f32x16){0};
        LAS unsigned char* kb = lds + L_K + sk + hi * 1024 + r32 * 16;
#pragma unroll
        for (int d0 = 0; d0 < 6; ++d0) { const bf16x8 a0 = *(const LAS bf16x8*)(kb + d0 * 2048), a1 = *(const LAS bf16x8*)(kb + d0 * 2048 + 512);
            p0 = __builtin_amdgcn_mfma_f32_32x32x16_bf16(a0, qr[d0], p0, 0, 0, 0); p1 = __builtin_amdgcn_mfma_f32_32x32x16_bf16(a1, qr[d0], p1, 0, 0, 0); }
        float rm = fmaxf(p0[0], p1[0]);
#pragma unroll
        for (int r = 1; r < 16; ++r) rm = fmaxf(rm, fmaxf(p0[r], p1[r]));
        rm = fmaxf(rm, __shfl_xor(rm, 32));
        if (__any(rm > mref + THR)) {
            const float mn = fmaxf(mref, rm), f = __builtin_amdgcn_exp2f(mref - mn); mref = mn; l *= f;
            if (hi == 0) wsf[r32] = f;
            LDS_WAIT();
#pragma unroll
            for (int r = 0; r < 16; ++r) { const float fr_ = wsf[crow(r, hi)]; o[0][r] *= fr_; o[1][r] *= fr_; }
        }
        float ls = 0.f;
#pragma unroll
        for (int r = 0; r < 16; ++r) { p0[r] = __builtin_amdgcn_exp2f(p0[r] - mref); p1[r] = __builtin_amdgcn_exp2f(p1[r] - mref); ls += p0[r] + p1[r]; }
        l += ls;
        v4u pw[4];
#pragma unroll
        for (int k = 0; k < 4; ++k) { pw[0][k] = pg8::cvt_pk_bf16(p0[2 * k], p0[2 * k + 1]); pw[1][k] = pg8::cvt_pk_bf16(p0[8 + 2 * k], p0[8 + 2 * k + 1]);
            pw[2][k] = pg8::cvt_pk_bf16(p1[2 * k], p1[2 * k + 1]); pw[3][k] = pg8::cvt_pk_bf16(p1[8 + 2 * k], p1[8 + 2 * k + 1]); }
#pragma unroll
        for (int d0 = 0; d0 < 2; ++d0)
#pragma unroll
            for (int ks = 0; ks < 4; ++ks) { LAS unsigned char* vp = lds + L_V + sv + d0 * 4096 + ks * 1024 + vlane;
                const s16x4 lo = __builtin_bit_cast(s16x4, __builtin_amdgcn_ds_read_tr16_b64_v4i16((LAS s16x4*)vp));
                const s16x4 hh = __builtin_bit_cast(s16x4, __builtin_amdgcn_ds_read_tr16_b64_v4i16((LAS s16x4*)(vp + 512)));
                const bf16x8 vf = (bf16x8){lo[0], lo[1], lo[2], lo[3], hh[0], hh[1], hh[2], hh[3]};
                o[d0] = __builtin_amdgcn_mfma_f32_32x32x16_bf16(__builtin_bit_cast(bf16x8, pw[ks]), vf, o[d0], 0, 0, 0); }
        { const int nk = sk + KSLOT, nv = sv + VSLOT; sk2 = sk; sv2 = sv; sk = (nk == 3 * KSLOT) ? 0 : nk; sv = (nv == 3 * VSLOT) ? 0 : nv; }
    }
#undef MLA_DMA
    l += __shfl_xor(l, 32);
    if (hi == 0) wsf[32 + r32] = 1.0f / l;
    LDS_WAIT();
    LAS bf16* stg = (LAS bf16*)(lds + L_OST) + wid * 2048;
#pragma unroll
    for (int r = 0; r < 16; ++r) { const int orow = crow(r, hi); const float rl = wsf[32 + orow];
#pragma unroll
        for (int d0 = 0; d0 < 2; ++d0) stg[orow * 64 + d0 * 32 + r32] = (bf16)f2bf(o[d0][r] * rl); }
    LDS_WAIT();
    bf16* Y1 = (bf16*)(F.ws + WS_U);
#pragma unroll
    for (int i = 0; i < 4; ++i) { const int row = i * 8 + (lane >> 3), ch = lane & 7; const v4u ov = *(const LAS v4u*)(stg + row * 64 + ch * 8);
        const size_t grow = rowbase + q0 + wid * 32 + row; const v4u gv = *(const GAS v4u*)(C1 + grow * NBP + GATE1_OFF + h * 64 + ch * 8);
        v4u rr;
#pragma unroll
        for (int k = 0; k < 4; ++k) rr[k] = pk2(bflo(ov[k]) * silu_f(bflo(gv[k])), bfhi(ov[k]) * silu_f(bfhi(gv[k])));
        *(GAS v4u*)(Y1 + grow * DM + h * 64 + ch * 8) = rr; }
    asm volatile("s_waitcnt vmcnt(0) lgkmcnt(0)\n\ts_barrier" ::: "memory");
}
}

namespace mla2 {
constexpr int KVBLK = 64, NT = SEQ / KVBLK, KSLOT = 12288, NKS = 4, VSLOT = 8192, NVS = 3;
constexpr int L_K = 0, L_V = NKS * KSLOT, L_WS = L_V + NVS * VSLOT, L_OST = L_WS + NWAVES * 256, L_END = L_OST + NWAVES * 4096;
static_assert(L_END <= RING_BYTES, "mla2 LDS");
typedef LAS const unsigned char* lds_cptr;
#define SBAR() __builtin_amdgcn_sched_barrier(0)
#define PIN(x) asm volatile("" : "+v"(x))
#define MFMA32(a, b, c) __builtin_amdgcn_mfma_f32_32x32x16_bf16(a, b, c, 0, 0, 0)
#define WAIT_BAR(N) asm volatile("s_waitcnt vmcnt(" #N ") lgkmcnt(0)\n\ts_barrier" ::: "memory")
#define MX3(a, b, c) __builtin_fmaxf(__builtin_fmaxf((a), (b)), (c))
#define EX(v) __builtin_amdgcn_exp2f(v)
__device__ __forceinline__ unsigned cvtpk_s(float lo, float hi) { typedef float f2 __attribute__((ext_vector_type(2))); typedef __bf16 b2 __attribute__((ext_vector_type(2))); f2 v = {lo, hi}; b2 b = __builtin_convertvector(v, b2); return __builtin_bit_cast(unsigned, b); }
__device__ __forceinline__ s16x4 vtr(lds_cptr p) { return __builtin_bit_cast(s16x4, __builtin_amdgcn_ds_read_tr16_b64_v4i16((LAS s16x4*)p)); }
template <int THRL>
__device__ __forceinline__ void unit(Frame& F, int b, int h, int qb) {
    LAS unsigned char* lds = F.lds; const int lane = F.lane, wid = F.wave, r32 = lane & 31, hi = lane >> 5;
    const size_t rowbase = (size_t)b * SEQ; const int q0 = qb * 256;
    const bf16* KV1 = (const bf16*)(F.ws + WS_KV1); const bf16* C1N = (const bf16*)(F.ws + WS_C1N); const bf16* Q1 = (const bf16*)(F.ws + WS_Q1); const bf16* C1 = (const bf16*)(F.ws + WS_C1);
    const bf16* ksrc = KV1 + (rowbase + lane) * KVW + h * 128 + wid * 8;
    const bf16* krsrc = C1N + (rowbase + lane) * C1N_LD + QL + KVL + (wid & 3) * 8;
    const bf16* vsrc = KV1 + (rowbase + 16 * (wid & 3) + (lane >> 2)) * KVW + h * 128 + 64 + (wid >> 2) * 32 + (lane & 3) * 8;
    const unsigned lds0 = (unsigned)(uintptr_t)lds;
    const unsigned kdst = lds0 + L_K + wid * 1024, krdst = lds0 + L_K + (8 + (wid & 3)) * 1024, vdst = lds0 + L_V + wid * 1024;
    const bool w4 = wid < 4;
#define DMA_K(t, sk) do { mla::glds16(ksrc + (size_t)(t) * KVBLK * KVW, (unsigned)__builtin_amdgcn_readfirstlane(kdst + (sk))); \
        if (w4) mla::glds16(krsrc + (size_t)(t) * KVBLK * C1N_LD, (unsigned)__builtin_amdgcn_readfirstlane(krdst + (sk))); } while (0)
#define DMA_V(t, sv) mla::glds16(vsrc + (size_t)(t) * KVBLK * KVW, (unsigned)__builtin_amdgcn_readfirstlane(vdst + (sv)))
#define WB2() do { if (w4) WAIT_BAR(3); else WAIT_BAR(2); } while (0)
    DMA_K(0, 0); DMA_V(0, 0); DMA_K(1, KSLOT); DMA_K(2, 2 * KSLOT);
    const bf16* qrow = Q1 + (rowbase + q0 + wid * 32 + r32) * QW + h * 96;
    bf16x8 qr[6];
#pragma unroll
    for (int d0 = 0; d0 < 6; ++d0) qr[d0] = *(const GAS bf16x8*)(qrow + d0 * 16 + hi * 8);
    { const f32x4* cs = (const f32x4*)((const f32x2*)(F.ws + WS_ROPE) + (size_t)(q0 + wid * 32 + r32) * 16 + 8 * hi);
      v4u a = __builtin_bit_cast(v4u, qr[4]), c2 = __builtin_bit_cast(v4u, qr[5]);
#pragma unroll
      for (int k = 0; k < 4; ++k) { const f32x4 cc = cs[k];
          const float x1a = bflo(a[k]), x1b = bfhi(a[k]), x2a = bflo(c2[k]), x2b = bfhi(c2[k]);
          a[k] = pk2(x1a * cc.x - x2a * cc.y, x1b * cc.z - x2b * cc.w); c2[k] = pk2(x2a * cc.x + x1a * cc.y, x2b * cc.z + x1b * cc.w); }
      qr[4] = __builtin_bit_cast(bf16x8, a); qr[5] = __builtin_bit_cast(bf16x8, c2); }
    LAS float* wsf = (LAS float*)(lds + L_WS) + wid * 64;
    const lds_cptr kp0 = (lds_cptr)lds + L_K + hi * 1024 + r32 * 16;
    const lds_cptr vp0 = (lds_cptr)lds + L_V + ((lane >> 4) & 1) * 32 + (lane & 3) * 8 + (4 * hi + ((lane & 15) >> 2)) * 64;
#define KFR(g, ks) (*(const LAS bf16x8*)(kp0 + (ks) + ((g) >> 1) * 2048 + ((g) & 1) * 512))
    float mhat = 0.f, l_reg = 0.f; f32x16 o[2]; o[0] = (f32x16){0}; o[1] = (f32x16){0}; f32x16 negm = (f32x16){0}; asm volatile("" : "+v"(negm));
    bool resc = false;
    f32x16 pA0, pA1, pB0, pB1; bf16x8 kf[12]; v4u pw0, pw1, pw2, pw3; s16x4 vlo[3], vhi[3];
    WAIT_BAR(0);
    {
#pragma unroll
        for (int g = 0; g < 12; ++g) kf[g] = KFR(g, 0);
        pA0 = MFMA32(kf[0], qr[0], negm); pA1 = MFMA32(kf[1], qr[0], negm);
#pragma unroll
        for (int d0 = 1; d0 < 6; ++d0) { pA0 = MFMA32(kf[2 * d0], qr[d0], pA0); pA1 = MFMA32(kf[2 * d0 + 1], qr[d0], pA1); }
        float a = MX3(pA0[0], pA0[1], pA1[0]), bb = MX3(pA0[2], pA0[3], pA1[1]); a = MX3(a, pA1[2], pA1[3]);
#pragma unroll
        for (int r = 4; r < 16; r += 4) { a = MX3(a, pA0[r], pA0[r + 1]); bb = MX3(bb, pA0[r + 2], pA0[r + 3]); a = MX3(a, pA1[r], pA1[r + 1]); bb = MX3(bb, pA1[r + 2], pA1[r + 3]); }
        float rm = __builtin_fmaxf(a, bb); { auto rr = __builtin_amdgcn_permlane32_swap(__float_as_uint(rm), __float_as_uint(rm), false, false); rm = __builtin_fmaxf(__uint_as_float(rr[0]), __uint_as_float(rr[1])); }
        mhat = rm;
#pragma unroll
        for (int r = 0; r < 16; ++r) { pA0[r] = EX(pA0[r] - rm); pA1[r] = EX(pA1[r] - rm); negm[r] = -mhat; }
        asm volatile("" : "+v"(negm));
    }
    DMA_K(3, 3 * KSLOT); DMA_V(1, VSLOT);
    kf[0] = KFR(0, KSLOT); kf[1] = KFR(1, KSLOT);
    WB2();
    int kc = KSLOT, vprev = 0;
#define PKW(P, B) cvtpk_s(P[B], P[B + 1])
#define PAF(k) __builtin_bit_cast(bf16x8, pw##k)
#define VF(i) (bf16x8){vlo[i][0], vlo[i][1], vlo[i][2], vlo[i][3], vhi[i][0], vhi[i][1], vhi[i][2], vhi[i][3]}
#define VRD(set, i) do { vlo[set] = vtr(vp_ + (((i) >> 2) * 4096 + ((i) & 3) * 1024)); vhi[set] = vtr(vp_ + (((i) >> 2) * 4096 + ((i) & 3) * 1024 + 512)); } while (0)
#define GAPA4(MF, KR, A0, A1, A2, A3, W0, PW) do { MF; KR; sacc += A0; sacc += A1; sacc += A2; sacc += A3; PIN(sacc); W0; PIN(PW); SBAR(); } while (0)
#define GAPA42(MF, KR, A0, A1, A2, A3, W0, W1, PW) do { MF; KR; sacc += A0; sacc += A1; sacc += A2; sacc += A3; PIN(sacc); W0; W1; PIN(PW); SBAR(); } while (0)
#define GAPA1(MF, W0, PW) do { MF; W0; PIN(PW); SBAR(); } while (0)
#define GAPB(PRE, MF, X, B) do { PRE; MF; X[B] = EX(X[B]); X[B + 1] = EX(X[B + 1]); X[B + 2] = EX(X[B + 2]); X[B + 3] = EX(X[B + 3]); PIN(X); SBAR(); } while (0)
#define STEP(C0, C1, P0, P1, t, GK, GV, GL) do { SBAR(); \
    const int kn_ = (kc + KSLOT == NKS * KSLOT) ? 0 : kc + KSLOT; const int kp_ = (kc == 0) ? (NKS - 1) * KSLOT : kc - KSLOT; \
    const int vn_ = (vprev + 2 * VSLOT >= NVS * VSLOT) ? vprev + 2 * VSLOT - NVS * VSLOT : vprev + 2 * VSLOT; \
    const lds_cptr vp_ = vp0 + vprev; \
    kf[2] = KFR(2, kc); kf[3] = KFR(3, kc); SBAR(); \
    float sacc = (P0[0] + P0[1]); \
    GAPA4(C0 = MFMA32(kf[0], qr[0], negm), kf[4] = KFR(4, kc),   P0[2], P0[3], P0[4], P0[5],     pw0[0] = PKW(P0, 0), pw0); \
    GAPA4(C1 = MFMA32(kf[1], qr[0], negm), kf[5] = KFR(5, kc),   P0[6], P0[7], P0[8], P0[9],     pw0[1] = PKW(P0, 2), pw0); \
    GAPA4(C0 = MFMA32(kf[2], qr[1], C0),   kf[6] = KFR(6, kc),   P0[10], P0[11], P0[12], P0[13], pw0[2] = PKW(P0, 4), pw0); \
    GAPA4(C1 = MFMA32(kf[3], qr[1], C1),   kf[7] = KFR(7, kc),   P0[14], P0[15], P1[0], P1[1],   pw0[3] = PKW(P0, 6), pw0); \
    GAPA42(C0 = MFMA32(kf[4], qr[2], C0),  kf[8] = KFR(8, kc),   P1[2], P1[3], P1[4], P1[5],     pw1[0] = PKW(P0, 8), pw1[1] = PKW(P0, 10), pw1); \
    GAPA42(C1 = MFMA32(kf[5], qr[2], C1),  kf[9] = KFR(9, kc),   P1[6], P1[7], P1[8], P1[9],     pw1[2] = PKW(P0, 12), pw1[3] = PKW(P0, 14), pw1); \
    GAPA42(C0 = MFMA32(kf[6], qr[3], C0),  kf[10] = KFR(10, kc), P1[10], P1[11], P1[12], P1[13], pw2[0] = PKW(P1, 0), pw2[1] = PKW(P1, 2), pw2); \
    GAPA42(C1 = MFMA32(kf[7], qr[3], C1),  kf[11] = KFR(11, kc), P1[14], P1[15], 0.f, 0.f,       pw2[2] = PKW(P1, 4), pw2[3] = PKW(P1, 6), pw2); \
    GAPA1(C0 = MFMA32(kf[8], qr[4], C0),  pw3[0] = PKW(P1, 8), pw3); \
    GAPA1(C1 = MFMA32(kf[9], qr[4], C1),  pw3[1] = PKW(P1, 10), pw3); \
    GAPA1(C0 = MFMA32(kf[10], qr[5], C0), pw3[2] = PKW(P1, 12), pw3); \
    GAPA1(C1 = MFMA32(kf[11], qr[5], C1), pw3[3] = PKW(P1, 14), pw3); \
    l_reg += sacc; \
    if (GK) { DMA_K((t) + 3, kp_); } if (GV) { DMA_V((t) + 1, vn_); } \
    VRD(0, 0); VRD(1, 4); SBAR(); \
    { float a = MX3(C0[0], C0[1], C1[0]), b_ = MX3(C0[2], C0[3], C1[1]); a = MX3(a, C1[2], C1[3]); \
      _Pragma("unroll") for (int r = 4; r < 16; r += 4) { a = MX3(a, C0[r], C0[r + 1]); b_ = MX3(b_, C0[r + 2], C0[r + 3]); a = MX3(a, C1[r], C1[r + 1]); b_ = MX3(b_, C1[r + 2], C1[r + 3]); } \
      float rm = __builtin_fmaxf(a, b_); { auto rr = __builtin_amdgcn_permlane32_swap(__float_as_uint(rm), __float_as_uint(rm), false, false); rm = __builtin_fmaxf(__uint_as_float(rr[0]), __uint_as_float(rr[1])); } \
      resc = false; \
      if (__builtin_expect(__any(rm > (float)THRL), 0)) { const float dl = __builtin_fmaxf(rm, 0.f); mhat += dl; \
        _Pragma("unroll") for (int r = 0; r < 16; ++r) { C0[r] -= dl; C1[r] -= dl; } \
        _Pragma("unroll") for (int r = 0; r < 16; ++r) negm[r] = -mhat; asm volatile("" : "+v"(negm)); \
        const float f = __builtin_amdgcn_exp2f(-dl); l_reg *= f; if (hi == 0) wsf[r32] = f; resc = true; } } \
    SBAR(); \
    GAPB(VRD(2, 1), o[0] = MFMA32(PAF(0), VF(0), o[0]), C0, 0); \
    GAPB(VRD(0, 5), o[1] = MFMA32(PAF(0), VF(1), o[1]), C0, 4); \
    GAPB(VRD(1, 2), o[0] = MFMA32(PAF(1), VF(2), o[0]), C0, 8); \
    GAPB(VRD(2, 6), o[1] = MFMA32(PAF(1), VF(0), o[1]), C0, 12); \
    GAPB(VRD(0, 3), o[0] = MFMA32(PAF(2), VF(1), o[0]), C1, 0); \
    GAPB(do { VRD(1, 7); if (GL) kf[0] = KFR(0, kn_); } while (0), o[1] = MFMA32(PAF(2), VF(2), o[1]), C1, 4); \
    GAPB(do { if (GL) kf[1] = KFR(1, kn_); } while (0), o[0] = MFMA32(PAF(3), VF(0), o[0]), C1, 8); \
    GAPB((void)0, o[1] = MFMA32(PAF(3), VF(1), o[1]), C1, 12); \
    kc = kn_; vprev = (vprev + VSLOT == NVS * VSLOT) ? 0 : vprev + VSLOT; \
    } while (0)
#define RESC() do { if (resc) { LDS_WAIT(); _Pragma("unroll") for (int d_ = 0; d_ < 2; ++d_) _Pragma("unroll") for (int r = 0; r < 16; ++r) o[d_][r] *= wsf[crow(r, hi)]; } } while (0)
    int t = 1;
    for (; t + 3 < NT; t += 2) {
        STEP(pB0, pB1, pA0, pA1, t, true, true, true);     WB2(); RESC();
        STEP(pA0, pA1, pB0, pB1, t + 1, true, true, true); WB2(); RESC();
    }
    STEP(pB0, pB1, pA0, pA1, NT - 3, false, true, true);  WAIT_BAR(1); RESC();
    STEP(pA0, pA1, pB0, pB1, NT - 2, false, true, true);  WAIT_BAR(1); RESC();
    STEP(pB0, pB1, pA0, pA1, NT - 1, false, false, false); WAIT_BAR(0); RESC();
    { float sacc = 0.f;
#pragma unroll
      for (int r = 0; r < 16; ++r) sacc += pB0[r] + pB1[r];
      l_reg += sacc;
      pw0 = (v4u){PKW(pB0, 0), PKW(pB0, 2), PKW(pB0, 4), PKW(pB0, 6)}; pw1 = (v4u){PKW(pB0, 8), PKW(pB0, 10), PKW(pB0, 12), PKW(pB0, 14)};
      pw2 = (v4u){PKW(pB1, 0), PKW(pB1, 2), PKW(pB1, 4), PKW(pB1, 6)}; pw3 = (v4u){PKW(pB1, 8), PKW(pB1, 10), PKW(pB1, 12), PKW(pB1, 14)};
      const lds_cptr vp_ = vp0 + vprev;
#pragma unroll
      for (int dh = 0; dh < 2; ++dh) {
          VRD(0, dh * 4 + 0); o[dh] = MFMA32(PAF(0), VF(0), o[dh]); VRD(1, dh * 4 + 1); o[dh] = MFMA32(PAF(1), VF(1), o[dh]);
          VRD(2, dh * 4 + 2); o[dh] = MFMA32(PAF(2), VF(2), o[dh]); VRD(0, dh * 4 + 3); o[dh] = MFMA32(PAF(3), VF(0), o[dh]); } }
    { auto rr = __builtin_amdgcn_permlane32_swap(__float_as_uint(l_reg), __float_as_uint(l_reg), false, false); l_reg = __uint_as_float(rr[0]) + __uint_as_float(rr[1]); }
    if (hi == 0) wsf[32 + r32] = 1.0f / l_reg;
    LDS_WAIT();
    LAS bf16* stg = (LAS bf16*)(lds + L_OST) + wid * 2048;
#pragma unroll
    for (int r = 0; r < 16; ++r) { const int orow = crow(r, hi); const float rl = wsf[32 + orow];
#pragma unroll
        for (int d0 = 0; d0 < 2; ++d0) stg[orow * 64 + d0 * 32 + r32] = (bf16)f2bf(o[d0][r] * rl); }
    LDS_WAIT();
    bf16* Y1 = (bf16*)(F.ws + WS_U);
#pragma unroll
    for (int i = 0; i < 4; ++i) { const int row = i * 8 + (lane >> 3), ch = lane & 7; const v4u ov = *(const LAS v4u*)(stg + row * 64 + ch * 8);
        const size_t grow = rowbase + q0 + wid * 32 + row; const v4u gv = *(const GAS v4u*)(C1 + grow * NBP + GATE1_OFF + h * 64 + ch * 8);
        v4u rr;
#pragma unroll
        for (int k = 0; k < 4; ++k) rr[k] = pk2(bflo(ov[k]) * silu_f(bflo(gv[k])), bfhi(ov[k]) * silu_f(bfhi(gv[k])));
        *(GAS v4u*)(Y1 + grow * DM + h * 64 + ch * 8) = rr; }
    asm volatile("s_waitcnt vmcnt(0) lgkmcnt(0)\n\ts_barrier" ::: "memory");
#undef DMA_K
#undef DMA_V
#undef WB2
#undef KFR
#undef PKW
#undef PAF
#undef VF
#undef VRD
#undef GAPA4
#undef GAPA42
#undef GAPA1
#undef GAPB
#undef STEP
#undef RESC
}
#undef SBAR
#undef PIN
#undef MFMA32
#undef WAIT_BAR
#undef MX3
#undef EX
}

constexpr int NPHASES = 13;
struct Args { const float* in[15]; float* out; unsigned char* ws; int ph_lo, ph_hi; };
__global__ void __launch_bounds__(NTHREADS, 2) fwd_kernel(Args args) {
    extern __shared__ __attribute__((aligned(16))) unsigned char lds_raw[];
    Frame F;
    F.lds = (LAS unsigned char*)lds_raw;
    F.tid = threadIdx.x; F.lane = F.tid & 63; F.wave = __builtin_amdgcn_readfirstlane(F.tid >> 6);
    F.G = gridDim.x; { const int bx = blockIdx.x; F.vcu = (F.G % 8 == 0) ? (bx % 8) * (F.G / 8) + bx / 8 : bx; }
    F.x = args.in[0]; F.c = args.in[1]; F.rel_bias = args.in[2]; F.ada_w = args.in[3]; F.ada_b = args.in[4]; F.ln_g = args.in[5]; F.ln_b = args.in[6];
    F.a_w_in = args.in[7]; F.a_w_out = args.in[8]; F.b_w_in = args.in[9]; F.b_q_norm = args.in[10]; F.b_w_uq = args.in[11]; F.b_kv_norm = args.in[12]; F.b_w_ukv = args.in[13]; F.b_w_out = args.in[14];
    F.out = args.out; F.ws = args.ws;
    volatile LAS unsigned* MISC = (volatile LAS unsigned*)(F.lds + MISC_OFF);
    for (int u = F.tid; u < (LDS_BYTES - LDSCTL_OFF) / 4; u += NTHREADS) ((LAS unsigned*)(F.lds + LDSCTL_OFF))[u] = 0u;
    __syncthreads();
    gu32* ctl = (gu32*)(F.ws + WS_CTL);
    const int lo = args.ph_lo, hi = args.ph_hi;
#if MK_PER_PHASE
#define GRID_BAR() do { } while (0)
#else
    XcdBarrier bar = xcd_barrier_post((unsigned*)(ctl + CW_BAR), MISC + 8);
#define GRID_BAR() xcd_barrier(bar)
#endif
#define IN(k) (lo <= (k) && (k) < hi)
#define REP(k) for (int rep_ = 0; rep_ < (((DOUBLE_MASK >> (k)) & 1) ? 2 : 1); ++rep_)
#define SEAM(k) do { if (IN(k) && IN((k) + 1)) GRID_BAR(); } while (0)
    (void)MISC; (void)ctl;
    bf16* U = (bf16*)(F.ws + WS_U);
    if (IN(0)) REP(0) { p0_prologue(F); } SEAM(0);
    if (IN(1)) REP(1) { p0b_modulate(F); } SEAM(1);
    if (IN(2)) REP(2) { pg8::Gemm g{U, (const bf16*)(F.ws + WS_WIN0), M, NA, DM, DM}; pg8::StaticOrder S; S.init(M, NA, F.G, (int)blockIdx.x);
        pg8::EpiBf16 E{(bf16*)(F.ws + WS_QKVG), NA}; pg8::gemm_phase<pg8::EpiBf16, pg8::StaticOrder>(F.lds, g, S, E); } SEAM(2);
    if (IN(3)) REP(3) { for (int u = F.vcu; u < dil::NUNITS; u += F.G) dil::unit(F, u); } SEAM(3);
    if (IN(4)) REP(4) { p2b_combine(F); } SEAM(4);
    if (IN(5)) REP(5) { pg8::Gemm g{(const bf16*)(F.ws + WS_O0), (const bf16*)(F.ws + WS_WOUT0), M, DM, WA, WA}; pg8::StaticOrder S; S.init(M, DM, F.G, (int)blockIdx.x);
        pg8::EpiBf16 E{(bf16*)(F.ws + WS_Z), DM}; pg8::gemm_phase<pg8::EpiBf16, pg8::StaticOrder>(F.lds, g, S, E); } SEAM(5);
    if (IN(6)) REP(6) { ln_pass<true>(F, F.x, (const bf16*)(F.ws + WS_Z), F.out, 0, U); } SEAM(6);
    if (IN(7)) REP(7) { pg8::Gemm g{U, (const bf16*)(F.ws + WS_WIN1), M, NBP, DM, DM}; pg8::StaticOrder S; S.init(M, NBP, F.G, (int)blockIdx.x);
        pg8::EpiBf16 E{(bf16*)(F.ws + WS_C1), NBP}; pg8::gemm_phase<pg8::EpiBf16, pg8::StaticOrder>(F.lds, g, S, E); } SEAM(7);
    if (IN(8)) REP(8) { p4b_norm_rope(F); } SEAM(8);
    if (IN(9)) REP(9) {
        { pg8::Gemm g{(const bf16*)(F.ws + WS_C1N), (const bf16*)(F.ws + WS_WUQ), M, QW, QL, C1N_LD}; pg8::StaticOrder S; S.init(M, QW, F.G, (int)blockIdx.x);
          pg8::EpiBf16 E{(bf16*)(F.ws + WS_Q1), QW}; pg8::gemm_phase<pg8::EpiBf16, pg8::StaticOrder>(F.lds, g, S, E); }
        { pg8::Gemm g{(const bf16*)(F.ws + WS_C1N) + QL, (const bf16*)(F.ws + WS_WUKV), M, KVW, 256, C1N_LD}; pg8::StaticOrder S; S.init(M, KVW, F.G, (int)blockIdx.x);
          pg8::EpiBf16 E{(bf16*)(F.ws + WS_KV1), KVW}; pg8::gemm_phase<pg8::EpiBf16, pg8::StaticOrder>(F.lds, g, S, E); }
    } SEAM(9);
    if (IN(10)) REP(10) {
        const int xg = F.vcu / 32, cl = F.vcu % 32;
        if (F.G == 256) { for (int i = 0; i < 8; ++i) { const int pair = xg * 16 + i * 2 + (cl >> 4);
#if MLA_TUNED
            mla2::unit<8>(F, pair / HB, pair % HB, cl & 15);
#else
            mla::unit(F, pair / HB, pair % HB, cl & 15);
#endif
        } }
        else { for (int u = F.vcu; u < mla::NUNITS; u += F.G) mla::unit(F, u / (HB * 16), (u / 16) % HB, u & 15); }
    } SEAM(10);
    if (IN(11)) REP(11) { pg8::Gemm g{U, (const bf16*)(F.ws + WS_WOUT1), M, DM, DM, DM}; pg8::StaticOrder S; S.init(M, DM, F.G, (int)blockIdx.x);
        pg8::EpiBf16 E{(bf16*)(F.ws + WS_Z), DM}; pg8::gemm_phase<pg8::EpiBf16, pg8::StaticOrder>(F.lds, g, S, E); } SEAM(11);
    if (IN(12)) REP(12) { ln_pass<false>(F, F.out, (const bf16*)(F.ws + WS_Z), F.out, 1, nullptr); }
#undef IN
#undef SEAM
}

#if SELFCHECK
namespace chk {
struct CArgs { const float* in[15]; float* out; unsigned char* ws; };
__device__ __forceinline__ unsigned hash32(unsigned x) { x ^= x >> 16; x *= 0x7feb352dU; x ^= x >> 15; x *= 0x846ca68bU; x ^= x >> 16; return x; }
__device__ __forceinline__ void report(unsigned char* ws, int stage, float e) { if (!(e >= 0.f)) e = 1e30f; atomicMax((unsigned*)(ws + WS_CTL) + CW_ERR + stage, __float_as_uint(e)); }
__device__ __forceinline__ void rmsacc(unsigned char* ws, int stage, float se, float sr) { atomicAdd((float*)(ws + WS_CTL) + CW_ERR + 32 + 2 * stage, se); atomicAdd((float*)(ws + WS_CTL) + CW_ERR + 33 + 2 * stage, sr); }
__device__ __forceinline__ float wsum(float v) { for (int o = 1; o < 64; o <<= 1) v += __shfl_xor(v, o); return v; }
__device__ __forceinline__ float wmax(float v) { for (int o = 1; o < 64; o <<= 1) v = fmaxf(v, __shfl_xor(v, o)); return v; }
__global__ void __launch_bounds__(64) k_mod(CArgs a) { const int s = blockIdx.x, lane = threadIdx.x, i = s & 1, b = (s >> 1) & 7, n = hash32(s) % (3 * DM);
    float acc = 0.f; for (int k = lane; k < DM; k += 64) acc += silu_f(a.in[1][b * DM + k]) * a.in[3][((size_t)i * DM + k) * 3 * DM + n];
    const float ref = wsum(acc) + a.in[4][i * 3 * DM + n], got = ((const float*)(a.ws + WS_MOD))[(size_t)(i * 8 + b) * 3 * DM + n];
    if (lane == 0) report(a.ws, 1, fabsf(got - ref) / (fabsf(ref) + 0.1f) / 1e-4f); }
__global__ void __launch_bounds__(64) k_weights(CArgs a) { const int s = blockIdx.x * 64 + threadIdx.x; const unsigned hsh = hash32(s), h2 = hash32(s + 0x9e3779b9u); const int m = s % 7; float expv = 0.f, got = 0.f;
    if (m == 0) { const int n = hsh % NA, k = h2 % DM; expv = a.in[7][(size_t)k * NA + n] * (n < WA ? QSCALE_A : 1.f); got = bf2f(((const bf16*)(a.ws + WS_WIN0))[(size_t)n * DM + k]); }
    else if (m == 1) { const int n = hsh % DM, k = h2 % WA; expv = a.in[8][(size_t)k * DM + n]; got = bf2f(((const bf16*)(a.ws + WS_WOUT0))[(size_t)n * WA + k]); }
    else if (m == 2) { const int n = hsh % NBP, k = h2 % DM; expv = n < NBIN ? a.in[9][(size_t)k * NBIN + n] : 0.f; got = bf2f(((const bf16*)(a.ws + WS_WIN1))[(size_t)n * DM + k]); }
    else if (m == 3) { const int n = hsh % QW, k = h2 % QL; expv = a.in[11][(size_t)k * QW + n] * (QSCALE_B * a.in[10][k]); got = bf2f(((const bf16*)(a.ws + WS_WUQ))[(size_t)n * QL + k]); }
    else if (m == 4) { const int n = hsh % KVW, k = h2 % 256; expv = k < KVL ? a.in[13][(size_t)k * KVW + n] * a.in[12][k] : 0.f; got = bf2f(((const bf16*)(a.ws + WS_WUKV))[(size_t)n * 256 + k]); }
    else if (m == 5) { const int n = hsh % DM, k = h2 % DM; expv = a.in[14][(size_t)k * DM + n]; got = bf2f(((const bf16*)(a.ws + WS_WOUT1))[(size_t)n * DM + k]); }
    else { const int pos = hsh % SEQ, fi = h2 % 16; const double ang = (double)((float)pos * (float)pow(10000.0, -(double)(2 * fi) / 32.0)); const f32x2 cs = ((const f32x2*)(a.ws + WS_ROPE))[pos * 16 + fi];
        report(a.ws, 2, fmaxf(fabsf(cs.x - (float)cos(ang)), fabsf(cs.y - (float)sin(ang))) / 2e-3f); return; }
    report(a.ws, 2, fabsf(got - bf2f((bf16)f2bf(expv))) / (fabsf(expv) + 1e-4f) / 1e-2f); }
__global__ void __launch_bounds__(64) k_u0(CArgs a) { const int s = blockIdx.x * 64 + threadIdx.x; const int row = hash32(s) % M, col = hash32(s + 77777u) % DM, b = row / SEQ; const float* mod = (const float*)(a.ws + WS_MOD) + (size_t)b * 3 * DM;
    const float ref = a.in[0][(size_t)row * DM + col] * (1.f + mod[DM + col]) + mod[col], got = bf2f(((const bf16*)(a.ws + WS_U))[(size_t)row * DM + col]);
    report(a.ws, 3, fabsf(got - ref) / (fabsf(ref) + 0.02f) / 1e-2f); }
__global__ void __launch_bounds__(64) k_gemm(unsigned char* ws, const bf16* A, int lda, const bf16* Bt, int K, const bf16* C, int ldc, int N, int stage, float flr) { const int s = blockIdx.x, lane = threadIdx.x; const int row = hash32(s * 2 + 1) % M, col = hash32(s * 2 + 2 + stage * 1000003) % N;
    float acc = 0.f; for (int k = lane; k < K; k += 64) acc += bf2f(A[(size_t)row * lda + k]) * bf2f(Bt[(size_t)col * K + k]);
    const float ref = wsum(acc), got = bf2f(C[(size_t)row * ldc + col]); if (lane == 0) { report(ws, stage, fabsf(got - ref) / (fabsf(ref) + flr) / 1e-2f); rmsacc(ws, stage, (got - ref) * (got - ref), ref * ref); } }
__global__ void __launch_bounds__(64) k_dil(CArgs a) { const int s = blockIdx.x, lane = threadIdx.x; const int row = hash32(s * 3 + 5) % M, h = hash32(s * 3 + 6) % HA, b = row / SEQ, t = row % SEQ, g = h / 6, d = g == 0 ? 1 : (g == 1 ? 4 : 16);
    const bf16* QKVG = (const bf16*)(a.ws + WS_QKVG); const bf16* q = QKVG + (size_t)row * NA + h * 64;
    float sc[3]; float mx = -3e38f;
    for (int i = 0; i < 3; ++i) { const int mi = lane + 64 * i - 64; sc[i] = -3e38f; const int tk = t + mi * d;
        if (mi <= 64 && tk >= 0 && tk < SEQ) { const bf16* k = QKVG + ((size_t)b * SEQ + tk) * NA + WA + h * 64; float dot = 0.f; for (int e = 0; e < 64; ++e) dot += bf2f(q[e]) * bf2f(k[e]);
            sc[i] = dot + a.in[2][dil::t5_bucket(mi * d) * HA + h] * LOG2E; } mx = fmaxf(mx, sc[i]); }
    mx = wmax(mx); float l = 0.f; __shared__ float o[64 * 64]; for (int e = 0; e < 64; ++e) o[e * 64 + lane] = 0.f;
    for (int i = 0; i < 3; ++i) { const int mi = lane + 64 * i - 64; const int tk = t + mi * d; if (sc[i] > -1e38f) { const float p = exp2f(sc[i] - mx); l += p; const bf16* v = QKVG + ((size_t)b * SEQ + tk) * NA + 2 * WA + h * 64; for (int e = 0; e < 64; ++e) o[e * 64 + lane] += p * bf2f(v[e]); } }
    l = wsum(l); float worst = 0.f, rmax = 0.f, se = 0.f, sr = 0.f;
    for (int e = 0; e < 64; ++e) { const float ref = wsum(o[e * 64 + lane]) / l, got = bf2f(((const bf16*)(a.ws + WS_O0))[(size_t)row * WA + h * 64 + e]); worst = fmaxf(worst, fabsf(got - ref)); rmax = fmaxf(rmax, fabsf(ref)); se += (got - ref) * (got - ref); sr += ref * ref; }
    worst = worst / (rmax + 0.02f);
    const float lref = (mx + log2f(l)) * LN2, lgot = ((const float*)(a.ws + WS_LSE))[(size_t)row * HA + h]; worst = fmaxf(worst, fabsf(lgot - lref) / (fabsf(lref) + 1.f));
    if (lane == 0) { report(a.ws, 5, worst / 2e-2f); rmsacc(a.ws, 5, se, sr); rmsacc(a.ws, 15, (lgot - lref) * (lgot - lref), 1.0f); } }
__global__ void __launch_bounds__(64) k_y0_pre(CArgs a, float* side) { const int s = blockIdx.x * 64 + threadIdx.x; const int row = hash32(s * 5 + 1) % M, col = hash32(s * 5 + 2) % WA, head = col / 64, hg = head % 6, g = head / 6; const float* L = (const float*)(a.ws + WS_LSE) + (size_t)row * HA;
    const float l0 = L[hg], l1 = L[6 + hg], l2 = L[12 + hg], mxl = fmaxf(l0, fmaxf(l1, l2)), e0 = expf(l0 - mxl), e1 = expf(l1 - mxl), e2 = expf(l2 - mxl), w = (g == 0 ? e0 : (g == 1 ? e1 : e2)) / (e0 + e1 + e2);
    const float o = bf2f(((const bf16*)(a.ws + WS_O0))[(size_t)row * WA + col]), gt = bf2f(((const bf16*)(a.ws + WS_QKVG))[(size_t)row * NA + 3 * WA + col]); side[s] = o * w * gt / (1.f + expf(-gt)); }
__global__ void __launch_bounds__(64) k_y0_post(CArgs a, const float* side) { const int s = blockIdx.x * 64 + threadIdx.x; const int row = hash32(s * 5 + 1) % M, col = hash32(s * 5 + 2) % WA; const float ref = side[s], got = bf2f(((const bf16*)(a.ws + WS_O0))[(size_t)row * WA + col]);
    report(a.ws, 6, fabsf(got - ref) / (fabsf(ref) + 0.01f) / 1e-2f); }
__global__ void __launch_bounds__(64) k_ln0(CArgs a) { const int s = blockIdx.x, lane = threadIdx.x; const int row = hash32(s * 7 + 3) % M, b = row / SEQ; const float* mod0 = (const float*)(a.ws + WS_MOD) + (size_t)b * 3 * DM; const float* mod1 = (const float*)(a.ws + WS_MOD) + (size_t)(8 + b) * 3 * DM;
    float v[16]; float sm = 0.f; for (int j = 0; j < 16; ++j) { const int c = lane + 64 * j; v[j] = ALPHA * a.in[0][(size_t)row * DM + c] + mod0[2 * DM + c] * bf2f(((const bf16*)(a.ws + WS_Z))[(size_t)row * DM + c]); sm += v[j]; }
    const float mean = wsum(sm) / DM; float s2 = 0.f; for (int j = 0; j < 16; ++j) { v[j] -= mean; s2 += v[j] * v[j]; } const float rstd = 1.f / sqrtf(wsum(s2) / DM + LN_EPS); float worst = 0.f;
    for (int j = 0; j < 16; ++j) { const int c = lane + 64 * j; const float x1 = v[j] * rstd * a.in[5][c] + a.in[6][c], g1 = a.out[(size_t)row * DM + c]; worst = fmaxf(worst, fabsf(g1 - x1) / (fabsf(x1) + 0.1f) / 1e-4f);
        const float u1 = x1 * (1.f + mod1[DM + c]) + mod1[c], gu = bf2f(((const bf16*)(a.ws + WS_U))[(size_t)row * DM + c]); worst = fmaxf(worst, fabsf(gu - u1) / (fabsf(u1) + 0.02f) / 1e-2f); }
    worst = wmax(worst); if (lane == 0) report(a.ws, 8, worst); }
__global__ void __launch_bounds__(64) k_c1n(CArgs a) { const int s = blockIdx.x, lane = threadIdx.x; const int row = hash32(s * 11 + 3) % M; const bf16* r = (const bf16*)(a.ws + WS_C1) + (size_t)row * NBP; const bf16* o = (const bf16*)(a.ws + WS_C1N) + (size_t)row * C1N_LD;
    float sq = 0.f, sk = 0.f; for (int c = lane; c < QL; c += 64) sq += bf2f(r[c]) * bf2f(r[c]); for (int c = lane; c < KVL; c += 64) sk += bf2f(r[QL + c]) * bf2f(r[QL + c]);
    const float rq = 1.f / sqrtf(wsum(sq) / QL + RMS_EPS), rk = 1.f / sqrtf(wsum(sk) / KVL + RMS_EPS); float worst = 0.f;
    for (int c = lane; c < C1N_LD; c += 64) { float ref; if (c < QL) ref = bf2f(r[c]) * rq; else if (c < QL + KVL) ref = bf2f(r[c]) * rk; else if (c < GATE1_OFF) { const int i = (c - QL - KVL) & 15; const bool second = (c - QL - KVL) >= 16;
            const float x1 = bf2f(r[QL + KVL + i]), x2 = bf2f(r[QL + KVL + 16 + i]); const float inv = powf(10000.f, -(float)(2 * i) / 32.f), ang = (float)(row % SEQ) * inv; ref = second ? (x2 * cosf(ang) + x1 * sinf(ang)) : (x1 * cosf(ang) - x2 * sinf(ang)); } else ref = 0.f;
        worst = fmaxf(worst, fabsf(bf2f(o[c]) - ref) / (fabsf(ref) + 0.02f) / 1e-2f); }
    worst = wmax(worst); if (lane == 0) report(a.ws, 10, worst); }
__global__ void __launch_bounds__(64) k_mla(CArgs a) { const int s = blockIdx.x, lane = threadIdx.x; const int row = hash32(s * 13 + 1) % M, h = hash32(s * 13 + 2) % HB, b = row / SEQ, pos = row % SEQ;
    const bf16* Q1 = (const bf16*)(a.ws + WS_Q1) + (size_t)row * QW + h * 96; const bf16* KV1 = (const bf16*)(a.ws + WS_KV1); const bf16* C1N = (const bf16*)(a.ws + WS_C1N); const bf16* C1 = (const bf16*)(a.ws + WS_C1);
    __shared__ float q[96]; __shared__ float o[64 * 64]; if (lane == 0) { for (int e = 0; e < 64; ++e) q[e] = bf2f(Q1[e]);
    for (int i = 0; i < 16; ++i) { const float inv = powf(10000.f, -(float)(2 * i) / 32.f), ang = (float)pos * inv, c = cosf(ang), sn = sinf(ang), x1 = bf2f(Q1[64 + i]), x2 = bf2f(Q1[80 + i]); q[64 + i] = x1 * c - x2 * sn; q[80 + i] = x2 * c + x1 * sn; } }
    __syncthreads();
    float mx = -3e38f; for (int kk = lane; kk < SEQ; kk += 64) { const size_t kr = (size_t)b * SEQ + kk; float dot = 0.f; for (int e = 0; e < 64; ++e) dot += q[e] * bf2f(KV1[kr * KVW + h * 128 + e]); for (int e = 0; e < 32; ++e) dot += q[64 + e] * bf2f(C1N[kr * C1N_LD + QL + KVL + e]); mx = fmaxf(mx, dot); }
    mx = wmax(mx); float l = 0.f; for (int e = 0; e < 64; ++e) o[e * 64 + lane] = 0.f;
    for (int kk = lane; kk < SEQ; kk += 64) { const size_t kr = (size_t)b * SEQ + kk; float dot = 0.f; for (int e = 0; e < 64; ++e) dot += q[e] * bf2f(KV1[kr * KVW + h * 128 + e]); for (int e = 0; e < 32; ++e) dot += q[64 + e] * bf2f(C1N[kr * C1N_LD + QL + KVL + e]);
        const float p = exp2f(dot - mx); l += p; for (int e = 0; e < 64; ++e) o[e * 64 + lane] += p * bf2f(KV1[kr * KVW + h * 128 + 64 + e]); }
    l = wsum(l); float worst = 0.f, rmax = 0.f, se = 0.f, sr = 0.f;
    for (int e = 0; e < 64; ++e) { const float gt = bf2f(C1[(size_t)row * NBP + GATE1_OFF + h * 64 + e]); const float ref = wsum(o[e * 64 + lane]) / l * gt / (1.f + expf(-gt)), got = bf2f(((const bf16*)(a.ws + WS_U))[(size_t)row * DM + h * 64 + e]); worst = fmaxf(worst, fabsf(got - ref)); rmax = fmaxf(rmax, fabsf(ref)); se += (got - ref) * (got - ref); sr += ref * ref; }
    if (lane == 0) { report(a.ws, 13, worst / (rmax + 0.001f) / 3e-2f); rmsacc(a.ws, 13, se, sr); } }
#ifndef REPORT_STAGE
#define REPORT_STAGE 0
#endif
__global__ void __launch_bounds__(64) k_report(CArgs a) { if (REPORT_STAGE > 0) { const float* acc = (const float*)(a.ws + WS_CTL) + CW_ERR + 32 + 2 * REPORT_STAGE; const float rms = sqrtf(acc[0] / fmaxf(acc[1], 1e-30f));
        float V = -10.f * log10f(fmaxf(rms, 1e-10f)); V = fminf(fmaxf(V, 1.f), 99.f); a.out[0] = V; return; }
    const unsigned* err = (const unsigned*)(a.ws + WS_CTL) + CW_ERR; for (int st = 1; st < 16; ++st) { const float e = __uint_as_float(err[st]); if (e > 1.0f) { int mag = (int)log2f(e); mag = mag > 9 ? 9 : mag; a.out[0] = 100.f * st + 10.f * mag; return; } } }
}
#endif

extern "C" void kernel_launch(void* const* d_in, const int* in_sizes, int n_in, void* d_out, int out_size, void* d_ws, size_t ws_size, hipStream_t stream) {
    static int grid = 0;
    if (grid == 0) {
        if (n_in != 15 || in_sizes[0] != M * DM || out_size != M * DM || ws_size < WS_END) { fprintf(stderr, "kernel_launch: unexpected shapes (n_in %d, in0 %d, out %d, ws %zu < %zu)\n", n_in, n_in > 0 ? in_sizes[0] : -1, out_size, ws_size, (size_t)WS_END); grid = -1; return; }
        int dev = 0, cus = 0;
        if (hipGetDevice(&dev) != hipSuccess || hipDeviceGetAttribute(&cus, hipDeviceAttributeMultiprocessorCount, dev) != hipSuccess) { grid = -1; return; }
        if (hipFuncSetAttribute((const void*)fwd_kernel, hipFuncAttributeMaxDynamicSharedMemorySize, LDS_BYTES) != hipSuccess) { fprintf(stderr, "kernel_launch: hipFuncSetAttribute failed\n"); grid = -1; return; }
        grid = cus;
    }
    if (grid < 0) return;
    (void)hipMemsetAsync((char*)d_ws + WS_CTL, 0, CTL_ZERO_BYTES, stream);
    Args a{};
    for (int i = 0; i < 15; ++i) a.in[i] = (const float*)d_in[i];
    a.out = (float*)d_out; a.ws = (unsigned char*)d_ws;
#if MK_PER_PHASE
#if SELFCHECK
    chk::CArgs ca{}; for (int i = 0; i < 15; ++i) ca.in[i] = a.in[i]; ca.out = a.out; ca.ws = a.ws; unsigned char* ws = a.ws; float* side = (float*)(ws + WS_END);
#endif
    for (int p = 0; p < NPHASES; ++p) {
#if SELFCHECK
        if (p == 4) hipLaunchKernelGGL(chk::k_y0_pre, dim3(64), dim3(64), 0, stream, ca, side);
#endif
        a.ph_lo = p; a.ph_hi = p + 1; hipLaunchKernelGGL(fwd_kernel, dim3(grid), dim3(NTHREADS), LDS_BYTES, stream, a);
#if SELFCHECK
        if (p == 0) { hipLaunchKernelGGL(chk::k_mod, dim3(1024), dim3(64), 0, stream, ca); hipLaunchKernelGGL(chk::k_weights, dim3(512), dim3(64), 0, stream, ca); }
        if (p == 1) hipLaunchKernelGGL(chk::k_u0, dim3(256), dim3(64), 0, stream, ca);
        if (p == 2) hipLaunchKernelGGL(chk::k_gemm, dim3(4096), dim3(64), 0, stream, ws, (const bf16*)(ws + WS_U), DM, (const bf16*)(ws + WS_WIN0), DM, (const bf16*)(ws + WS_QKVG), NA, NA, 4, 0.05f);
        if (p == 3) hipLaunchKernelGGL(chk::k_dil, dim3(2048), dim3(64), 0, stream, ca);
        if (p == 4) hipLaunchKernelGGL(chk::k_y0_post, dim3(64), dim3(64), 0, stream, ca, (const float*)side);
        if (p == 5) hipLaunchKernelGGL(chk::k_gemm, dim3(4096), dim3(64), 0, stream, ws, (const bf16*)(ws + WS_O0), WA, (const bf16*)(ws + WS_WOUT0), WA, (const bf16*)(ws + WS_Z), DM, DM, 7, 0.005f);
        if (p == 6) hipLaunchKernelGGL(chk::k_ln0, dim3(512), dim3(64), 0, stream, ca);
        if (p == 7) hipLaunchKernelGGL(chk::k_gemm, dim3(4096), dim3(64), 0, stream, ws, (const bf16*)(ws + WS_U), DM, (const bf16*)(ws + WS_WIN1), DM, (const bf16*)(ws + WS_C1), NBP, NBP, 9, 0.05f);
        if (p == 8) hipLaunchKernelGGL(chk::k_c1n, dim3(512), dim3(64), 0, stream, ca);
        if (p == 9) { hipLaunchKernelGGL(chk::k_gemm, dim3(4096), dim3(64), 0, stream, ws, (const bf16*)(ws + WS_C1N), C1N_LD, (const bf16*)(ws + WS_WUQ), QL, (const bf16*)(ws + WS_Q1), QW, QW, 11, 0.05f);
                      hipLaunchKernelGGL(chk::k_gemm, dim3(4096), dim3(64), 0, stream, ws, (const bf16*)(ws + WS_C1N) + QL, C1N_LD, (const bf16*)(ws + WS_WUKV), 256, (const bf16*)(ws + WS_KV1), KVW, KVW, 12, 0.05f); }
        if (p == 10) hipLaunchKernelGGL(chk::k_mla, dim3(1024), dim3(64), 0, stream, ca);
        if (p == 11) hipLaunchKernelGGL(chk::k_gemm, dim3(4096), dim3(64), 0, stream, ws, (const bf16*)(ws + WS_U), DM, (const bf16*)(ws + WS_WOUT1), DM, (const bf16*)(ws + WS_Z), DM, DM, 14, 0.0005f);
#endif
    }
#if SELFCHECK
    hipLaunchKernelGGL(chk::k_report, dim3(1), dim3(1), 0, stream, ca);
#endif
#else
    a.ph_lo = 0; a.ph_hi = NPHASES; hipLaunchKernelGGL(fwd_kernel, dim3(grid), dim3(NTHREADS), LDS_BYTES, stream, a);
#endif
}
```
